# Optimizing an MI355X kernel written in HIP

```python
import math
import jax, jax.numpy as jnp
from jax import lax
import numpy as np

D_MODEL = 1024
BATCH = 8
SEQ = 8192
DEPTH = 1
DEC_BATCH = 1
DEC_SEQ = 16384
PAST_LEN = 128

FNET_GROUPS = 4
FNET_GROUP_DIM = 128
FNET_WIDTH = FNET_GROUPS * FNET_GROUP_DIM
SSM_GROUP_DIM = 16
SSM_GROUPS = 32
SSM_WIDTH = SSM_GROUPS * SSM_GROUP_DIM
SSM_STATE = 64
N_DIR = 2
DT_MIN = 1e-3
DT_MAX = 1e-1
IN_WIDTH = FNET_WIDTH + SSM_WIDTH + 2 * D_MODEL
FFN_HIDDEN = int(math.ceil(8 * D_MODEL / 3 / 256) * 256)
EPS = 1e-6

kernel_name = "hybrid_fnet_s5_gated_encoder"


def rms_norm(x, g):
    xf = x.astype(jnp.float32)
    y = xf * lax.rsqrt(jnp.mean(xf * xf, axis=-1, keepdims=True) + EPS)
    return (y * g.astype(jnp.float32)).astype(x.dtype)


def fourier_mix(u):
    b, s, _ = u.shape
    ug = u.astype(jnp.float32).reshape(b, s, FNET_GROUPS, FNET_GROUP_DIM)
    f = jnp.fft.fftn(ug, axes=(1, 3), norm="ortho").real
    return f.reshape(b, s, FNET_WIDTH).astype(u.dtype)


def _scan_op(left, right):
    a_l, b_l = left
    a_r, b_r = right
    return a_r * a_l, a_r * b_l + b_r


def ssm_direction(u, lam_re, lam_im, log_dt, b_re, b_im, c_re, c_im, reverse):
    f32 = jnp.float32
    lam = lax.complex(lam_re.astype(f32), lam_im.astype(f32))
    dt = jnp.exp(log_dt.astype(f32))[:, None]
    lam_bar = jnp.exp(lam * dt)
    b = lax.complex(b_re.astype(f32), b_im.astype(f32))
    b_bar = ((lam_bar - 1.0) / lam)[:, :, None] * b
    bu = jnp.einsum('sgh,gph->sgp', u.astype(jnp.complex64), b_bar)
    a = jnp.broadcast_to(lam_bar, bu.shape)
    _, states = lax.associative_scan(_scan_op, (a, bu), reverse=reverse, axis=0)
    c = lax.complex(c_re.astype(f32), c_im.astype(f32))
    return jnp.einsum('sgp,ghp->sgh', states, c).real


def ssm_sequence(u, lam_re, lam_im, log_dt, b_re, b_im, c_re, c_im, d_skip):
    s = u.shape[0]
    ug = u.astype(jnp.float32).reshape(s, SSM_GROUPS, SSM_GROUP_DIM)
    y_fwd = ssm_direction(ug, lam_re[0], lam_im[0], log_dt[0], b_re[0], b_im[0], c_re[0], c_im[0], False)
    y_bwd = ssm_direction(ug, lam_re[1], lam_im[1], log_dt[1], b_re[1], b_im[1], c_re[1], c_im[1], True)
    y = y_fwd + y_bwd + d_skip.astype(jnp.float32).reshape(SSM_GROUPS, SSM_GROUP_DIM) * ug
    return y.reshape(s, SSM_WIDTH).astype(u.dtype)


def mixer(h, w_in, w_fnet_out, lam_re, lam_im, log_dt, b_re, b_im, c_re, c_im, d_skip,
          w_glu_val, w_glu_gate, w_out):
    proj = jnp.einsum('bsd,de->bse', h, w_in)
    o1 = FNET_WIDTH
    o2 = o1 + SSM_WIDTH
    o3 = o2 + D_MODEL
    u_f, u_s, g_a, g_b = proj[..., :o1], proj[..., o1:o2], proj[..., o2:o3], proj[..., o3:]
    br_a = jnp.einsum('bsf,fd->bsd', fourier_mix(u_f), w_fnet_out)
    y_s = lax.map(lambda u: ssm_sequence(u, lam_re, lam_im, log_dt, b_re, b_im, c_re, c_im, d_skip), u_s)
    z = jax.nn.gelu(y_s)
    br_b = jnp.einsum('bsf,fd->bsd', z, w_glu_val) * jax.nn.sigmoid(jnp.einsum('bsf,fd->bsd', z, w_glu_gate))
    merged = jax.nn.sigmoid(g_a) * br_a + jax.nn.sigmoid(g_b) * br_b
    return jnp.einsum('bsd,de->bse', merged, w_out)


def swiglu(h, w_gate, w_up, w_down):
    g = jnp.einsum('bsd,df->bsf', h, w_gate)
    u = jnp.einsum('bsd,df->bsf', h, w_up)
    return jnp.einsum('bsf,fd->bsd', jax.nn.silu(g) * u, w_down)


def encoder_stack(x, norm_mix_pre, norm_mix_post, norm_ffn_pre, norm_ffn_post, w_in, w_fnet_out,
                  lam_re, lam_im, log_dt, b_re, b_im, c_re, c_im, d_skip, w_glu_val, w_glu_gate,
                  w_out, w_ffn_gate, w_ffn_up, w_ffn_down):
    for l in range(DEPTH):
        h = rms_norm(x, norm_mix_pre[l])
        m = mixer(h, w_in[l], w_fnet_out[l], lam_re[l], lam_im[l], log_dt[l], b_re[l], b_im[l],
                  c_re[l], c_im[l], d_skip[l], w_glu_val[l], w_glu_gate[l], w_out[l])
        x = x + rms_norm(m, norm_mix_post[l])
        h = rms_norm(x, norm_ffn_pre[l])
        f = swiglu(h, w_ffn_gate[l], w_ffn_up[l], w_ffn_down[l])
        x = x + rms_norm(f, norm_ffn_post[l])
    return x


def setup_inputs(seed: int = 0) -> dict:
    key = jax.random.key(seed)
    ks = jax.random.split(key, 24)
    f32 = jnp.float32
    L = DEPTH

    def nrm(k, shape, fan_in):
        return jax.random.normal(k, shape, f32) * (fan_in ** -0.5)

    def gain(k):
        return 1.0 + 0.02 * jax.random.normal(k, (L, D_MODEL), f32)

    n_idx = jnp.arange(SSM_STATE, dtype=f32)
    lam_re = -0.5 + 0.01 * jax.random.normal(ks[6], (L, N_DIR, SSM_GROUPS, SSM_STATE), f32)
    lam_im = math.pi * n_idx + 0.01 * jax.random.normal(ks[7], (L, N_DIR, SSM_GROUPS, SSM_STATE), f32)
    log_dt = jax.random.uniform(ks[8], (L, N_DIR, SSM_GROUPS), f32,
                                minval=math.log(DT_MIN), maxval=math.log(DT_MAX))
    return {
        "x_prompt": jax.random.normal(ks[0], (BATCH, SEQ, D_MODEL), f32),
        "x_sample": jax.random.normal(ks[1], (DEC_BATCH, DEC_SEQ, D_MODEL), f32),
        "norm_mix_pre": gain(ks[2]),
        "norm_mix_post": gain(ks[3]),
        "norm_ffn_pre": gain(ks[4]),
        "norm_ffn_post": gain(ks[5]),
        "w_in": nrm(ks[9], (L, D_MODEL, IN_WIDTH), D_MODEL),
        "w_fnet_out": nrm(ks[10], (L, FNET_WIDTH, D_MODEL), FNET_WIDTH),
        "lam_re": lam_re,
        "lam_im": lam_im,
        "log_dt": log_dt,
        "b_re": nrm(ks[11], (L, N_DIR, SSM_GROUPS, SSM_STATE, SSM_GROUP_DIM), 2 * SSM_GROUP_DIM),
        "b_im": nrm(ks[12], (L, N_DIR, SSM_GROUPS, SSM_STATE, SSM_GROUP_DIM), 2 * SSM_GROUP_DIM),
        "c_re": nrm(ks[13], (L, N_DIR, SSM_GROUPS, SSM_GROUP_DIM, SSM_STATE), 2 * SSM_STATE),
        "c_im": nrm(ks[14], (L, N_DIR, SSM_GROUPS, SSM_GROUP_DIM, SSM_STATE), 2 * SSM_STATE),
        "d_skip": 1.0 + 0.1 * jax.random.normal(ks[15], (L, SSM_WIDTH), f32),
        "w_glu_val": nrm(ks[16], (L, SSM_WIDTH, D_MODEL), SSM_WIDTH),
        "w_glu_gate": nrm(ks[17], (L, SSM_WIDTH, D_MODEL), SSM_WIDTH),
        "w_out": nrm(ks[18], (L, D_MODEL, D_MODEL), D_MODEL),
        "w_ffn_gate": nrm(ks[19], (L, D_MODEL, FFN_HIDDEN), D_MODEL),
        "w_ffn_up": nrm(ks[20], (L, D_MODEL, FFN_HIDDEN), D_MODEL),
        "w_ffn_down": nrm(ks[21], (L, FFN_HIDDEN, D_MODEL), FFN_HIDDEN),
    }


def reference(x_prompt, x_sample, norm_mix_pre, norm_mix_post, norm_ffn_pre, norm_ffn_post, w_in,
              w_fnet_out, lam_re, lam_im, log_dt, b_re, b_im, c_re, c_im, d_skip, w_glu_val,
              w_glu_gate, w_out, w_ffn_gate, w_ffn_up, w_ffn_down):
    y_prompt = encoder_stack(x_prompt, norm_mix_pre, norm_mix_post, norm_ffn_pre, norm_ffn_post, w_in,
                             w_fnet_out, lam_re, lam_im, log_dt, b_re, b_im, c_re, c_im, d_skip,
                             w_glu_val, w_glu_gate, w_out, w_ffn_gate, w_ffn_up, w_ffn_down)
    y_sample = encoder_stack(x_sample, norm_mix_pre, norm_mix_post, norm_ffn_pre, norm_ffn_post, w_in,
                             w_fnet_out, lam_re, lam_im, log_dt, b_re, b_im, c_re, c_im, d_skip,
                             w_glu_val, w_glu_gate, w_out, w_ffn_gate, w_ffn_up, w_ffn_down)
    return (y_prompt, y_sample)
```

```cpp
#include <hip/hip_runtime.h>
#include <cstdio>
#include <cstdint>
#include <cmath>

#ifndef CFG_D
#define CFG_D 1024
#endif
#ifndef CFG_FFH
#define CFG_FFH 2816
#endif
#ifndef CFG_NPB
#define CFG_NPB 8
#endif
#ifndef CFG_SP
#define CFG_SP 8192
#endif
#ifndef CFG_SS
#define CFG_SS 16384
#endif
#define HD __host__ __device__ __forceinline__

typedef unsigned short bf16;
typedef short bf16x8 __attribute__((ext_vector_type(8)));
typedef float f32x4 __attribute__((ext_vector_type(4)));
typedef float f32x2 __attribute__((ext_vector_type(2)));
typedef unsigned u32x4 __attribute__((ext_vector_type(4)));
typedef unsigned u32x2 __attribute__((ext_vector_type(2)));

constexpr int D = CFG_D, FFH = CFG_FFH, NPB = CFG_NPB, SP = CFG_SP, SS = CFG_SS;
constexpr int TP = NPB * SP, T = TP + SS;
constexpr int NRH = T / 2 + 256 * (NPB + 1);
constexpr int FW = 512, SW = 512, NG = 32, GH = 16, NST = 64;
constexpr int NA = SW + 2 * D;
constexpr int LCH = 32, NCH = T / LCH, KU = GH * LCH, KROW = KU + 256;
constexpr int SHI = 128, KAH = SHI / 2 + 1, SLP = SP / SHI, SLS = SS / SHI;
constexpr float EPS = 1e-6f;
static_assert(T % 8192 == 0 && D % 256 == 0 && FFH % 128 == 0 && (2 * FFH) % 256 == 0 && SP % 256 == 0 && SS % 256 == 0, "tile shapes");
static_assert(SLP >= 64 && SLP <= 128 && SLS >= 64 && SLS <= 128 && KU == 512, "dft split (K = 2*S_lo must be a multiple of 128)");

constexpr size_t al(size_t x) { return (x + 4095) & ~(size_t)4095; }
constexpr size_t WS_CTL = 0, CTL_BYTES = 65536;
constexpr size_t WS_WA = al(WS_CTL + CTL_BYTES);
constexpr size_t WS_WF = al(WS_WA + (size_t)NA * D * 2);
constexpr size_t WS_WGLU = al(WS_WF + (size_t)FW * D * 2);
constexpr size_t WS_WFO = al(WS_WGLU + (size_t)2 * D * SW * 2);
constexpr size_t WS_WO = al(WS_WFO + (size_t)D * 2 * FW * 2);
constexpr size_t WS_WGU = al(WS_WO + (size_t)D * D * 2);
constexpr size_t WS_WDN = al(WS_WGU + (size_t)2 * FFH * D * 2);
constexpr size_t WS_A1 = al(WS_WDN + (size_t)D * FFH * 2);
constexpr size_t WS_A2P = al(WS_A1 + 256 * 256 * 2);
constexpr size_t WS_A2S = al(WS_A2P + 256 * 256 * 2);
constexpr size_t WS_TWP = al(WS_A2S + 256 * 256 * 2);
constexpr size_t WS_TWS = al(WS_TWP + (size_t)128 * SLP * 8);
constexpr size_t WS_KTAB = al(WS_TWS + (size_t)128 * SLS * 8);
constexpr size_t WS_WINT = al(WS_KTAB + (size_t)NG * 2 * LCH * 256 * 4);
constexpr size_t WS_MFT = al(WS_WINT + (size_t)NG * 256 * KU * 2);
constexpr size_t WS_LAML = al(WS_MFT + (size_t)NG * KU * KROW * 2);
constexpr size_t WS_IR1 = al(WS_LAML + (size_t)NG * 2 * 64 * 8);
constexpr size_t WS_IR0 = al(WS_IR1 + (size_t)T * 4);
constexpr size_t WS_ACT = al(WS_IR0 + (size_t)T * 4 + (1u << 19));
constexpr size_t UB = (size_t)T * D * 2;
constexpr size_t WS_R0 = WS_ACT;
constexpr size_t WS_R1 = al(WS_R0 + ((size_t)T * 1024 * 2 > UB ? (size_t)T * 1024 * 2 : UB));
constexpr size_t WS_R2 = al(WS_R1 + UB);
constexpr size_t WS_R3 = al(WS_R2 + UB);
constexpr size_t WS_R4 = al(WS_R3 + (size_t)NG * NCH * KROW * 2);
constexpr size_t WS_R5 = al(WS_R4 + (size_t)T * 512 * 2);
constexpr size_t WS_R6 = al(WS_R5 + (size_t)T * 1024 * 2 + 4096);
constexpr size_t WS_END0 = al(WS_R6 + ((size_t)NG * NCH * 256 * 2 > (size_t)NRH * D * 2 ? (size_t)NG * NCH * 256 * 2 : (size_t)NRH * D * 2));
constexpr size_t WS_AEND = al(WS_R2 + (size_t)T * FFH * 2);
constexpr size_t WS_END = WS_END0 > WS_AEND ? WS_END0 : WS_AEND;
static_assert(CFG_D != 1024 || WS_END <= ((size_t)1 << 30), "d_ws map exceeds 1 GiB");
static_assert((size_t)NRH * D * 2 <= UB && NRH % 256 == 0, "P / Q half-spectrum products fit their regions");

#if defined(__HIP_DEVICE_COMPILE__)
#define DEVCODE 1
#else
#define DEVCODE 0
#endif

HD unsigned f2bf(float f) { unsigned u = __builtin_bit_cast(unsigned, f); return (u + 0x7fffu + ((u >> 16) & 1u)) >> 16; }
HD float bf2f(unsigned b) { return __builtin_bit_cast(float, (b & 0xffffu) << 16); }
typedef __bf16 bf16x2_t __attribute__((ext_vector_type(2)));
HD unsigned pk2(float lo, float hi) {
#if DEVCODE
    const f32x2 v = {lo, hi}; const bf16x2_t b = __builtin_convertvector(v, bf16x2_t); return __builtin_bit_cast(unsigned, b);
#else
    return f2bf(lo) | (f2bf(hi) << 16);
#endif
}
HD u32x4 pk8(f32x4 a, f32x4 b) { u32x4 w; w.x = pk2(a[0], a[1]); w.y = pk2(a[2], a[3]); w.z = pk2(b[0], b[1]); w.w = pk2(b[2], b[3]); return w; }
HD void unpk8(u32x4 w, f32x4& a, f32x4& b) {
    a[0] = bf2f(w.x); a[1] = bf2f(w.x >> 16); a[2] = bf2f(w.y); a[3] = bf2f(w.y >> 16);
    b[0] = bf2f(w.z); b[1] = bf2f(w.z >> 16); b[2] = bf2f(w.w); b[3] = bf2f(w.w >> 16);
}
HD float fexp(float x) {
#if DEVCODE
    return __expf(x);
#else
    return expf(x);
#endif
}
HD float frcp(float x) {
#if DEVCODE
    return __builtin_amdgcn_rcpf(x);
#else
    return 1.0f / x;
#endif
}
HD float sigm(float x) { return frcp(1.0f + fexp(-x)); }
HD float fexp2(float x) {
#if DEVCODE
    return __builtin_amdgcn_exp2f(x);
#else
    return exp2f(x);
#endif
}
HD float sigm_ps(float xs) { return frcp(1.0f + fexp2(xs)); }
HD float gelu_tanh(float x) { const float y = 0.7978845608f * (x + 0.044715f * x * x * x); return x * frcp(1.0f + fexp(-2.0f * y)); }
HD void sincospi_(float x, float* s, float* c) {
#if DEVCODE
    sincospif(x, s, c);
#else
    *s = (float)sin(3.14159265358979323846 * (double)x); *c = (float)cos(3.14159265358979323846 * (double)x);
#endif
}
HD void cis_frac(long num, long den, float* c, float* s) { const long r = num % den; sincospi_(2.0f * (float)r / (float)den, s, c); }

HD int seq_start(int s) { return s < NPB ? s * SP : TP; }
HD int go_row0(int s) { return seq_start(s) / 2 + 256 * s; }
HD int opaque_int(int v) {
#if DEVCODE
    asm volatile("" : "+s"(v));
#endif
    return v; }

struct Ctx {
    const float* in[22]; float* out; unsigned char* ws;
    HD bf16* p16(size_t off) const { return (bf16*)(ws + off); }
    HD float* p32(size_t off) const { return (float*)(ws + off); }
    HD bf16* GO() const { return p16(WS_R0); }  HD bf16* MB() const { return p16(WS_R0); }
    HD bf16* PB() const { return p16(WS_R1); }  HD bf16* X1B() const { return p16(WS_R1); } HD bf16* FB() const { return p16(WS_R0); }  HD bf16* QB() const { return p16(WS_R6); }
    HD bf16* XB() const { return p16(WS_R2); }  HD bf16* AB() const { return p16(WS_R2); }  HD bf16* BRB() const { return p16(WS_R5); }
    HD bf16* US() const { return p16(WS_R3); }
    HD bf16* UT() const { return p16(WS_R4); }  HD bf16* Z() const { return p16(WS_R4); }
    HD bf16* PP() const { return p16(WS_R5); }
    HD bf16* X() const { return p16(WS_R6); }
    HD const float* xrow(int t) const { return t < TP ? in[0] + (size_t)t * D : in[1] + (size_t)(t - TP) * D; }
};
enum { I_XP = 0, I_XS, I_NMPRE, I_NMPOST, I_NFPRE, I_NFPOST, I_WIN, I_WFO, I_LRE, I_LIM, I_LDT, I_BRE, I_BIM, I_CRE, I_CIM, I_DSK, I_WGV, I_WGG, I_WOUT, I_WFG, I_WFU, I_WFD };

struct SsmState { float are, aim, cr, ci; };
HD SsmState ssm_state(const Ctx& C, int dir, int g, int p) {
    const int i = (dir * NG + g) * NST + p;
    const float lre = C.in[I_LRE][i], lim = C.in[I_LIM][i], dt = expf(C.in[I_LDT][dir * NG + g]);
    SsmState s; s.are = lre * dt; s.aim = lim * dt;
    float sn, cs; sincosf(s.aim, &sn, &cs); float sh, ch; sincosf(0.5f * s.aim, &sh, &ch);
    const float em1 = expm1f(s.are), e = em1 + 1.0f;
    const float nr = em1 * cs - 2.0f * sh * sh, ni = e * sn;
    const float inv = 1.0f / (lre * lre + lim * lim);
    s.cr = (nr * lre + ni * lim) * inv; s.ci = (ni * lre - nr * lim) * inv;
    return s;
}
HD void ssm_pow(const SsmState& s, float e, float& pr, float& pi) { const float m = expf(e * s.are); float sn, cs; sincosf(e * s.aim, &sn, &cs); pr = m * cs; pi = m * sn; }

#define LAS __attribute__((address_space(3)))
#define GAS __attribute__((address_space(1)))
#ifndef MK_ZEROC
#define MK_ZEROC 1
#endif
namespace pg8 {
constexpr int BM = 256, BK = 64, HALF = 128, HTB = HALF * BK * 2, STAGE_BYTES = 8 * HTB, NXCD = 8, WGM = 8;
HD int lds_byte(int r, int c) { const int st = (r >> 4) * 2 + (c >> 5), rr = r & 15, cc = c & 31, ob = rr * 64 + cc * 2; return st * 1024 + (ob ^ (((ob >> 9) & 1) << 5)); }
HD void stage_rc(int b, int& R, int& C) { const int st = b / 1024, sb = b % 1024, swz = sb ^ (((sb >> 9) & 1) << 5); R = (st >> 1) * 16 + swz / 64; C = (st & 1) * 32 + (swz % 64) / 2; }
HD int perm32(int rho) { const int n = rho >> 4, i = rho & 15; return 8 * (i >> 2) + 4 * n + (i & 3); }
struct Unit { const char* a; const char* b; int pm, pn, z; };
typedef f32x4 Acc[2][2][4][2];
HD bool static_order(int nM, int nN, int G, int c, int i, int& pm, int& pn) {
    const int nwg = nM * nN; const long L = (long)i * G + c; if (L >= nwg) return false;
    int wgid = (int)L; { const int q = nwg / NXCD, r = nwg % NXCD, xcd = wgid % NXCD, off = wgid / NXCD; wgid = (xcd < r ? xcd * (q + 1) : r * (q + 1) + (xcd - r) * q) + off; }
    const int nig = WGM * nN, gid = wgid / nig, fm = gid * WGM, gsz = (nM - fm) < WGM ? (nM - fm) : WGM;
    pm = fm + ((wgid % nig) % gsz); pn = (wgid % nig) / gsz; return true;
}
__device__ __forceinline__ f32x4 zero4() { f32x2 z = {0.f, 0.f}, lo, hi; asm volatile("v_pk_mov_b32 %0, %1, %1" : "=v"(lo) : "v"(z)); asm volatile("v_pk_mov_b32 %0, %1, %1" : "=v"(hi) : "v"(z)); return (f32x4){lo[0], lo[1], hi[0], hi[1]}; }
template <class P, bool ALIGN_EPI, bool SP2>
__device__ __forceinline__ void gemm_phase(LAS unsigned char* lds, const P& p) {
    int tid = threadIdx.x; asm volatile("" : "+v"(tid));
    const int wid = __builtin_amdgcn_readfirstlane(tid >> 6), lane = tid & 63, wr = wid >> 2, wc = wid & 3, fr = lane & 15, fq = lane >> 4;
    const int nt = p.K / BK;
    unsigned voffA[2], voffB[2];
#pragma unroll
    for (int i = 0; i < 2; ++i) { int R, C; stage_rc(tid * 16 + i * 8192, R, C); const int Rb = P::PERM ? ((R & ~31) + perm32(R & 31)) : R;
        voffA[i] = p.offA(R, C); voffB[i] = p.offB(Rb, C); }
    const size_t kstepA = p.kstepA, kstepB = p.kstepB;
    const size_t hstepA = p.hstepA, hstepB = p.hstepB;
    const unsigned ldsw = (unsigned)wid * 1024u;
    const int aoff = lds_byte(wr * 64 + fr, fq * 8), boff = lds_byte(wc * 32 + fr, fq * 8);
#define PG8_SA(b, h) (((b) * 2 + (h)) * HTB)
#define PG8_SB(b, h) ((4 + (b) * 2 + (h)) * HTB)
#define PG8_STAGE(bufoff, gbase, voff) do { _Pragma("unroll") for (int _i = 0; _i < 2; ++_i) \
        __builtin_amdgcn_global_load_lds((const unsigned*)((const char*)(gbase) + (voff)[_i]), (LAS unsigned*)(lds + (bufoff) + ldsw + _i * 8192), 16, 0, 0); } while (0)
#define PG8_LDA(dst, b, h) do { _Pragma("unroll") for (int m = 0; m < 4; ++m) _Pragma("unroll") for (int k = 0; k < 2; ++k) dst[m][k] = *(const LAS bf16x8*)(lds + PG8_SA(b, h) + aoff + m * 2048 + k * 1024); } while (0)
#define PG8_LDB(dst, b, h) do { _Pragma("unroll") for (int n = 0; n < 2; ++n) _Pragma("unroll") for (int k = 0; k < 2; ++k) dst[n][k] = *(const LAS bf16x8*)(lds + PG8_SB(b, h) + boff + n * 2048 + k * 1024); } while (0)
#define PG8_MMA(ai, bj, At, Bt) do { __builtin_amdgcn_s_setprio(1); _Pragma("unroll") for (int m = 0; m < 4; ++m) _Pragma("unroll") for (int n = 0; n < 2; ++n) _Pragma("unroll") for (int k = 0; k < 2; ++k) \
        acc[ai][bj][m][n] = __builtin_amdgcn_mfma_f32_16x16x32_bf16(Bt[n][k], At[m][k], acc[ai][bj][m][n], 0, 0, 0); __builtin_amdgcn_s_setprio(0); } while (0)
#define PG8_MMAZ(ai, bj, At, Bt) do { __builtin_amdgcn_s_setprio(1); \
        _Pragma("unroll") for (int m = 0; m < 4; ++m) _Pragma("unroll") for (int n = 0; n < 2; ++n) asm volatile("v_mfma_f32_16x16x32_bf16 %0, %1, %2, 0" : "+v"(acc[ai][bj][m][n]) : "v"(Bt[n][0]), "v"(At[m][0])); \
        _Pragma("unroll") for (int m = 0; m < 4; ++m) _Pragma("unroll") for (int n = 0; n < 2; ++n) acc[ai][bj][m][n] = __builtin_amdgcn_mfma_f32_16x16x32_bf16(Bt[n][1], At[m][1], acc[ai][bj][m][n], 0, 0, 0); \
        __builtin_amdgcn_s_setprio(0); } while (0)
#define PG8_WAIT_V(n) asm volatile("s_waitcnt vmcnt(" #n ")" ::: "memory")
#define PG8_WAIT_L(n) asm volatile("s_waitcnt lgkmcnt(" #n ")" ::: "memory")
#define PG8_ITER(MM) do { \
            PG8_LDB(B0, 0, 0); PG8_LDB(B1, 0, 1); PG8_SCHED; PG8_LDA(At, 0, 0); PG8_STAGE(PG8_SA(1, 1), a1 + hstepA, voffA); \
            PG8_WAIT_V(8); PG8_WAIT_L(0); PG8_BAR; MM(0, 0, At, B0); MM(0, 1, At, B1); PG8_BAR; PG8_SCHED; \
            PG8_LDA(At, 0, 1); PG8_STAGE(PG8_SB(0, 0), b2, voffB); PG8_STAGE(PG8_SB(0, 1), b2 + hstepB, voffB); PG8_STAGE(PG8_SA(0, 0), a2, voffA); \
            PG8_WAIT_V(8); PG8_WAIT_L(0); PG8_BAR; MM(1, 0, At, B0); MM(1, 1, At, B1); PG8_BAR; PG8_SCHED; \
            PG8_LDB(B0, 1, 0); PG8_LDB(B1, 1, 1); PG8_SCHED; PG8_LDA(At, 1, 0); PG8_STAGE(PG8_SA(0, 1), a2 + hstepA, voffA); \
            PG8_WAIT_V(8); PG8_WAIT_L(0); PG8_BAR; PG8_MMA(0, 0, At, B0); PG8_MMA(0, 1, At, B1); PG8_BAR; PG8_SCHED; \
            PG8_LDA(At, 1, 1); PG8_STAGE(PG8_SB(1, 0), b3, voffB); PG8_STAGE(PG8_SB(1, 1), b3 + hstepB, voffB); PG8_STAGE(PG8_SA(1, 0), a3, voffA); \
            PG8_WAIT_V(8); PG8_WAIT_L(0); PG8_BAR; PG8_MMA(1, 0, At, B0); PG8_MMA(1, 1, At, B1); PG8_BAR; PG8_SCHED; } while (0)
#define PG8_BAR __builtin_amdgcn_s_barrier()
#define PG8_SCHED __builtin_amdgcn_sched_barrier(0)
    Unit cur, nxt; int ui = 0;
    if (!p.next(0, cur)) return;
    Acc acc;
    if constexpr (!(MK_ZEROC && SP2)) {
#pragma unroll
    for (int a = 0; a < 2; ++a)
#pragma unroll
        for (int b = 0; b < 2; ++b)
#pragma unroll
            for (int m = 0; m < 4; ++m)
#pragma unroll
                for (int n = 0; n < 2; ++n) acc[a][b][m][n] = zero4(); }
    bf16x8 At[4][2], B0[2][2], B1[2][2];
    const char* cA = cur.a; const char* cB = cur.b;
    if constexpr (SP2) {
        PG8_STAGE(PG8_SB(0, 0), cB, voffB); PG8_STAGE(PG8_SB(0, 1), cB + hstepB, voffB); PG8_STAGE(PG8_SA(0, 0), cA, voffA); PG8_STAGE(PG8_SA(0, 1), cA + hstepA, voffA);
        if (wr == 1) PG8_BAR;
        PG8_WAIT_V(2); PG8_BAR;
        PG8_STAGE(PG8_SB(1, 0), cB + kstepB, voffB); PG8_STAGE(PG8_SA(1, 0), cA + kstepA, voffA); PG8_STAGE(PG8_SB(1, 1), cB + hstepB + kstepB, voffB);
        PG8_WAIT_V(6); PG8_BAR;
    } else {
        PG8_STAGE(PG8_SB(0, 0), cB, voffB); PG8_STAGE(PG8_SA(0, 0), cA, voffA); PG8_STAGE(PG8_SB(0, 1), cB + hstepB, voffB); PG8_STAGE(PG8_SA(0, 1), cA + hstepA, voffA);
        if (wr == 1) PG8_BAR;
        PG8_WAIT_V(4); PG8_BAR;
        PG8_STAGE(PG8_SB(1, 0), cB + kstepB, voffB); PG8_STAGE(PG8_SA(1, 0), cA + kstepA, voffA); PG8_STAGE(PG8_SB(1, 1), cB + hstepB + kstepB, voffB);
        PG8_WAIT_V(6); PG8_BAR;
    }
    for (;;) {
        const bool has_next = p.next(ui + 1, nxt);
        const char* nA = has_next ? nxt.a : cA; const char* nB = has_next ? nxt.b : cB;
#define PG8_PTRS(t) const bool last = ((t) == nt - 2); const char* a1 = cA + (size_t)((t) + 1) * kstepA; \
            const char* a2 = last ? nA : cA + (size_t)((t) + 2) * kstepA; const char* b2 = last ? nB : cB + (size_t)((t) + 2) * kstepB; const char* a3 = a2 + kstepA; const char* b3 = b2 + kstepB;
        if constexpr (MK_ZEROC && SP2) { PG8_PTRS(0); PG8_ITER(PG8_MMAZ); }
        for (int t = (MK_ZEROC && SP2) ? 2 : 0; t < nt; t += 2) {
            PG8_PTRS(t);
            if constexpr (SP2) {
            PG8_ITER(PG8_MMA);
            } else {
            PG8_LDB(B0, 0, 0); PG8_SCHED; PG8_LDA(At, 0, 0); PG8_STAGE(PG8_SA(1, 1), a1 + hstepA, voffA);
            PG8_WAIT_L(8); PG8_BAR; PG8_WAIT_L(0); PG8_MMA(0, 0, At, B0); PG8_BAR; PG8_SCHED;
            PG8_LDB(B1, 0, 1); PG8_STAGE(PG8_SB(0, 0), b2, voffB);
            PG8_BAR; PG8_WAIT_L(0); PG8_MMA(0, 1, At, B1); PG8_BAR;
            PG8_LDA(At, 0, 1); PG8_STAGE(PG8_SA(0, 0), a2, voffA);
            PG8_BAR; PG8_WAIT_L(0); PG8_MMA(1, 0, At, B0); PG8_BAR; PG8_SCHED;
            PG8_STAGE(PG8_SB(0, 1), b2 + hstepB, voffB);
            PG8_WAIT_V(6); PG8_BAR; PG8_MMA(1, 1, At, B1); PG8_BAR;
            PG8_LDB(B0, 1, 0); PG8_SCHED; PG8_LDA(At, 1, 0); PG8_STAGE(PG8_SA(0, 1), a2 + hstepA, voffA);
            PG8_WAIT_L(8); PG8_BAR; PG8_WAIT_L(0); PG8_MMA(0, 0, At, B0); PG8_BAR; PG8_SCHED;
            PG8_LDB(B1, 1, 1); PG8_STAGE(PG8_SB(1, 0), b3, voffB);
            PG8_BAR; PG8_WAIT_L(0); PG8_MMA(0, 1, At, B1); PG8_BAR;
            PG8_LDA(At, 1, 1); PG8_STAGE(PG8_SA(1, 0), a3, voffA);
            PG8_BAR; PG8_WAIT_L(0); PG8_MMA(1, 0, At, B0); PG8_BAR; PG8_SCHED;
            PG8_STAGE(PG8_SB(1, 1), b3 + hstepB, voffB);
            PG8_WAIT_V(6); PG8_BAR; PG8_MMA(1, 1, At, B1); PG8_BAR;
            }
        }
        if constexpr (ALIGN_EPI) { if (wr == 0) PG8_BAR; }
        p.epi(acc, cur, wr, wc, fr, fq);
        if (!has_next) break;
        if constexpr (!(MK_ZEROC && SP2)) {
#pragma unroll
        for (int a = 0; a < 2; ++a)
#pragma unroll
            for (int b = 0; b < 2; ++b)
#pragma unroll
                for (int m = 0; m < 4; ++m)
#pragma unroll
                    for (int n = 0; n < 2; ++n) acc[a][b][m][n] = zero4(); }
        cur = nxt; cA = nA; cB = nB; ++ui;
        if constexpr (ALIGN_EPI) { if (wr == 1) PG8_BAR; }
    }
    PG8_WAIT_V(0);
    if constexpr (!ALIGN_EPI) { if (wr == 0) PG8_BAR; }
    PG8_BAR;
#undef PG8_SA
#undef PG8_SB
#undef PG8_STAGE
#undef PG8_LDA
#undef PG8_LDB
#undef PG8_MMA
#undef PG8_WAIT_V
#undef PG8_MMAZ
#undef PG8_ITER
#undef PG8_PTRS
#undef PG8_WAIT_L
#undef PG8_BAR
#undef PG8_SCHED
}
}
using pg8::Unit; using pg8::Acc;

HD long xcd_remap(long L, long n) { const long q = n / 8, r = n % 8, x = L % 8, off = L / 8; return (x < r ? x * (q + 1) : r * (q + 1) + (x - r) * q) + off; }
struct ProbBase { int G, c; static constexpr size_t kstepA = 128, kstepB = 128; };

template <class E> struct ProbStd : ProbBase {
    static constexpr bool PERM = E::PERM;
    const bf16* A; const bf16* Bt; int M, N, K, lda, ldb; size_t hstepA, hstepB; E e;
    HD void init(const bf16* A_, int lda_, const bf16* Bt_, int ldb_, int M_, int N_, int K_, int G_, int c_) { A = A_; Bt = Bt_; lda = lda_; ldb = ldb_; M = M_; N = N_; K = K_; G = G_; c = c_;
        hstepA = (size_t)128 * lda * 2; hstepB = (size_t)128 * ldb * 2; }
    HD unsigned offA(int R, int C) const { return (unsigned)(R * lda) * 2u + (unsigned)C * 2u; }
    HD unsigned offB(int R, int C) const { return (unsigned)(R * ldb) * 2u + (unsigned)C * 2u; }
    HD bool next(int i, Unit& u) const { if (!pg8::static_order(M / 256, N / 256, G, c, i, u.pm, u.pn)) return false; u.z = 0;
        u.a = (const char*)A + (size_t)u.pm * 2 * hstepA; u.b = (const char*)Bt + (size_t)u.pn * 2 * hstepB; return true; }
    HD void epi(const Acc& acc, const Unit& u, int wr, int wc, int fr, int fq) const { e(acc, u, wr, wc, fr, fq); }
};
#define ROWLOOP for (int am_ = 0; am_ < 8; ++am_) if (const int ai = am_ >> 2, m = am_ & 3; true)
struct EpiUs { static constexpr bool PERM = true; bf16* US;
    HD void operator()(const Acc& acc, const Unit& u, int wr, int wc, int fr, int fq) const {
        const int row0 = u.pm * 256 + wr * 64 + fr, col0 = u.pn * 256 + wc * 32 + 8 * fq;
#pragma unroll
        ROWLOOP { const int tok = row0 + ai * 128 + m * 16, ch = tok / LCH, j = tok % LCH;
#pragma unroll
            for (int bj = 0; bj < 2; ++bj) { const int cs = col0 + bj * 128, g = cs >> 4, h0 = cs & 15;
                *(u32x4*)(US + ((size_t)(g * NCH + ch) * KROW + j * GH + h0)) = pk8(acc[ai][bj][m][0], acc[ai][bj][m][1]); } }
    }
};
struct EpiBf { static constexpr bool PERM = true; bf16* O; int ldc;
    HD void operator()(const Acc& acc, const Unit& u, int wr, int wc, int fr, int fq) const {
        const int row0 = u.pm * 256 + wr * 64 + fr, col0 = u.pn * 256 + wc * 32 + 8 * fq;
#pragma unroll
        ROWLOOP { bf16* rp = O + (size_t)(row0 + ai * 128 + m * 16) * ldc + col0;
#pragma unroll
            for (int bj = 0; bj < 2; ++bj) *(u32x4*)(rp + bj * 128) = pk8(acc[ai][bj][m][0], acc[ai][bj][m][1]); }
    }
};
struct ProbPQ : ProbBase { static constexpr bool PERM = true;
    const bf16* GO; const bf16* W; bf16* PB; bf16* QB; int K; size_t hstepA, hstepB;
    HD void init(const Ctx& C, int G_, int c_) { GO = C.GO(); W = C.p16(WS_WFO); PB = C.PB(); QB = C.QB(); K = FW; G = G_; c = c_; hstepA = (size_t)128 * 2048; hstepB = (size_t)128 * 2048; }
    HD unsigned offA(int R, int C) const { return (unsigned)(R * 2048) + (unsigned)C * 2u; }
    HD unsigned offB(int R, int C) const { return (unsigned)(R * 2048) + (unsigned)C * 2u; }
    HD bool next(int i, Unit& u) const { int pm2; if (!pg8::static_order(2 * (NRH / 256), D / 256, G, c, i, pm2, u.pn)) return false; u.z = pm2 >= NRH / 256; u.pm = pm2 - u.z * (NRH / 256);
        u.a = (const char*)GO + (size_t)u.pm * 2 * hstepA + (size_t)u.z * FW * 2; u.b = (const char*)W + (size_t)u.pn * 2 * hstepB + (size_t)u.z * FW * 2; return true; }
    HD void epi(const Acc& acc, const Unit& u, int wr, int wc, int fr, int fq) const { EpiBf e{u.z ? QB : PB, D}; e(acc, u, wr, wc, fr, fq); }
};
struct EpiGlu { static constexpr bool PERM = true; bf16* BRB;
    HD void operator()(const Acc& acc, const Unit& u, int wr, int wc, int fr, int fq) const {
        const int row0 = u.pm * 256 + wr * 64 + fr, col0 = u.pn * 128 + wc * 32 + 8 * fq;
#pragma unroll
        ROWLOOP { const size_t o = (size_t)(row0 + ai * 128 + m * 16) * D + col0;
            f32x4 v0 = acc[ai][0][m][0], v1 = acc[ai][0][m][1]; const f32x4 t0 = acc[ai][1][m][0], t1 = acc[ai][1][m][1];
#pragma unroll
            for (int q = 0; q < 4; ++q) { v0[q] = v0[q] * sigm_ps(t0[q]); v1[q] = v1[q] * sigm_ps(t1[q]); }
            *(u32x4*)(BRB + o) = pk8(v0, v1); }
    }
};
struct EpiGate { static constexpr bool PERM = true; const bf16* PB; const bf16* QB; bf16* BRB;
    HD void operator()(const Acc& acc, const Unit& u, int wr, int wc, int fr, int fq) const {
        const int row0 = u.pm * 256 + wr * 64 + fr, col0 = u.pn * 128 + wc * 32 + 8 * fq;
#pragma unroll
        ROWLOOP { const int t = row0 + ai * 128 + m * 16, sq = t < TP ? t / SP : NPB, S = sq < NPB ? SP : SS, tl = t - seq_start(sq);
            const bool lowh = 2 * tl <= S; const size_t r = (size_t)(go_row0(sq) + (lowh ? tl : S - tl)) * D + col0, o = (size_t)t * D + col0;
            f32x4 p0, p1, q0, q1, b0, b1; unpk8(*(const u32x4*)(PB + r), p0, p1); unpk8(*(const u32x4*)(QB + r), q0, q1); unpk8(*(const u32x4*)(BRB + o), b0, b1);
            const f32x4 a0 = lowh ? p0 + q0 : p0 - q0, a1 = lowh ? p1 + q1 : p1 - q1;
            f32x4 v0 = acc[ai][0][m][0], v1 = acc[ai][0][m][1]; const f32x4 t0 = acc[ai][1][m][0], t1 = acc[ai][1][m][1];
#pragma unroll
            for (int q = 0; q < 4; ++q) { v0[q] = sigm_ps(v0[q]) * a0[q] + sigm_ps(t0[q]) * b0[q]; v1[q] = sigm_ps(v1[q]) * a1[q] + sigm_ps(t1[q]) * b1[q]; }
            *(u32x4*)(BRB + o) = pk8(v0, v1); }
    }
};
struct EpiFfn { static constexpr bool PERM = true; bf16* AB;
    HD void operator()(const Acc& acc, const Unit& u, int wr, int wc, int fr, int fq) const {
        const int row0 = u.pm * 256 + wr * 64 + fr, col0 = u.pn * 128 + wc * 32 + 8 * fq;
#pragma unroll
        ROWLOOP { const size_t o = (size_t)(row0 + ai * 128 + m * 16) * FFH + col0;
            f32x4 v0 = acc[ai][0][m][0], v1 = acc[ai][0][m][1]; const f32x4 t0 = acc[ai][1][m][0], t1 = acc[ai][1][m][1];
#pragma unroll
            for (int q = 0; q < 4; ++q) { v0[q] = v0[q] * t0[q] * sigm_ps(v0[q]); v1[q] = v1[q] * t1[q] * sigm_ps(v1[q]); }
            __builtin_nontemporal_store(pk8(v0, v1), (u32x4*)(AB + o)); }
    }
};

struct ProbUT : ProbBase { static constexpr bool PERM = true;
    const bf16* WF; const bf16* XB; bf16* UT; int t0, nseq, S, SLO, K; size_t hstepA, hstepB;
    HD void init(const Ctx& C, int t0_, int nseq_, int S_, int G_, int c_) { WF = C.p16(WS_WF); XB = C.XB(); UT = C.UT(); t0 = t0_; nseq = nseq_; S = S_; SLO = S_ / SHI; K = D; G = G_; c = c_;
        hstepA = (size_t)128 * D * 2; hstepB = (size_t)D * 2; }
    HD unsigned offA(int R, int C) const { return (unsigned)(R * D) * 2u + (unsigned)C * 2u; }
    HD unsigned offB(int R, int C) const { return (unsigned)R * (unsigned)(SLO * D * 2) + (unsigned)C * 2u; }
    HD bool next(int i, Unit& u) const { long L = (long)i * G + c; const int nt = S / 256; if (L >= (long)2 * nseq * nt) return false; L = xcd_remap(L, (long)2 * nseq * nt);
        u.pm = (int)(L & 1); const int q = (int)(L >> 1); u.z = q / nt; u.pn = q % nt;
        u.a = (const char*)WF + (size_t)u.pm * 2 * hstepA; u.b = (const char*)XB + ((size_t)(t0 + u.z * S + 2 * u.pn) * D) * 2; return true; }
    HD void epi(const Acc& acc, const Unit& u, int wr, int wc, int fr, int fq) const {
        const int row0 = u.pm * 256 + wr * 64 + fr, col0 = u.pn * 256 + wc * 32 + 8 * fq; bf16* base = UT + (size_t)(t0 + u.z * S) * FW;
#pragma unroll
        ROWLOOP { bf16* rp = base + (size_t)(row0 + ai * 128 + m * 16) * S + col0;
#pragma unroll
            for (int bj = 0; bj < 2; ++bj) *(u32x4*)(rp + bj * 128) = pk8(acc[ai][bj][m][0], acc[ai][bj][m][1]); }
    }
};
constexpr int P2_NXU = NG * (NCH / 256), S1_NA = NPB - (NPB + 3) / 4, S1_NB = (NPB - S1_NA) * FW * (SP / SHI) / 256;
struct ProbS1 : ProbBase { static constexpr bool PERM = true;
    const bf16* A1; const bf16* UT; bf16* PP; const f32x2* TW; int t0, nseq, S, SLO, K; size_t hstepA, hstepB;
    HD void init(const Ctx& C, int t0_, int nseq_, int S_, const f32x2* tw, int G_, int c_) { A1 = C.p16(WS_A1); UT = C.UT() + (size_t)t0_ * FW; PP = C.PP() + (t0_ < TP ? (size_t)(t0_ / SP) * KAH * FW * 2 * (SP / SHI) : (size_t)t0_ * 1024); TW = tw; t0 = t0_; nseq = nseq_; S = S_; SLO = S_ / SHI; K = opaque_int(128); G = G_; c = c_;
        hstepA = (size_t)128 * 128 * 2; hstepB = (size_t)128 * 128 * 2; }
    HD unsigned offA(int R, int C) const { return (unsigned)R * 256u + (unsigned)C * 2u; }
    HD unsigned offB(int R, int C) const { return (unsigned)R * 256u + (unsigned)C * 2u; }
    HD bool next(int i, Unit& u) const { const long L = (long)i * G + c; if (L >= (long)nseq * FW * SLO / 256) return false;
        u.pm = 0; u.pn = (int)L; u.z = 0; u.a = (const char*)A1; u.b = (const char*)UT + (size_t)L * 256 * 256; return true; }
    HD void epi(const Acc& acc, const Unit& u, int wr, int wc, int fr, int fq) const {
#pragma unroll
        for (int m = 0; m < 4; ++m) { const int ka = wr * 64 + m * 16 + fr; if (ka < KAH) {
#pragma unroll
            for (int bj = 0; bj < 2; ++bj) { const int q = u.pn * 256 + bj * 128 + wc * 32 + 8 * fq, sl = q % SLO, cc = (q / SLO) % FW, sq = q / (SLO * FW);
                const f32x4* tw = (const f32x4*)(TW + (size_t)ka * SLO + sl);
                f32x4 orr[2], oii[2];
#pragma unroll
                for (int n = 0; n < 2; ++n) { const f32x4 re = acc[0][bj][m][n], im = acc[1][bj][m][n]; const f32x4 ta = tw[2 * n], tb = tw[2 * n + 1];
                    const f32x4 cs = (f32x4){ta[0], ta[2], tb[0], tb[2]}, sn = (f32x4){ta[1], ta[3], tb[1], tb[3]};
                    orr[n] = re * cs + im * sn; oii[n] = im * cs - re * sn; }
                bf16* dst = PP + ((size_t)((sq * KAH + ka) * FW + cc) * 2) * SLO + sl;
                *(u32x4*)dst = pk8(orr[0], orr[1]); *(u32x4*)(dst + SLO) = pk8(oii[0], oii[1]); } } }
    }
};
struct ProbS2 : ProbBase { static constexpr bool PERM = true;
    const bf16* A2; const bf16* PP; bf16* GO; int t0, sq0, nseq, S, SLO, K; size_t hstepA, hstepB;
    HD void init(const Ctx& C, int t0_, int nseq_, int S_, const bf16* a2, int G_, int c_) { A2 = a2; PP = C.PP() + (size_t)t0_ * 1024; GO = C.GO(); t0 = t0_; sq0 = t0_ < TP ? t0_ / SP : NPB; nseq = nseq_; S = S_; SLO = S_ / SHI; K = opaque_int(2 * SLO); G = G_; c = c_;
        hstepA = (size_t)128 * 2 * SLO * 2; hstepB = (size_t)128 * 2 * SLO * 2; }
    HD unsigned offA(int R, int C) const { return (unsigned)(R * 2 * SLO) * 2u + (unsigned)C * 2u; }
    HD unsigned offB(int R, int C) const { return (unsigned)(R * 2 * SLO) * 2u + (unsigned)C * 2u; }
    HD bool next(int i, Unit& u) const { const long L = (long)i * G + c; if (L >= (long)nseq * KAH * FW / 256) return false;
        u.pm = 0; u.pn = (int)L; u.z = 0; u.a = (const char*)A2; u.b = (const char*)PP + (size_t)L * 2 * hstepB; return true; }
    HD void epi(const Acc& acc, const Unit& u, int wr, int wc, int fr, int fq) const {
#pragma unroll
        for (int m = 0; m < 4; ++m) { const int kb = wr * 64 + m * 16 + fr; if (kb < SLO) {
#pragma unroll
            for (int bj = 0; bj < 2; ++bj) { const int q = u.pn * 256 + bj * 128 + wc * 32 + 8 * fq, cc = q % FW, ka = (q / FW) % KAH, sq = q / (FW * KAH);
                const int k = ka + SHI * kb, r0 = go_row0(sq0 + sq);
                if (2 * k <= S) { bf16* dst = GO + (size_t)(r0 + k) * 1024 + cc;
                    *(u32x4*)dst = pk8(acc[0][bj][m][0], acc[0][bj][m][1]); *(u32x4*)(dst + FW) = pk8(acc[1][bj][m][0], acc[1][bj][m][1]); }
                else if (ka > 0 && ka < SHI / 2) { bf16* dm = GO + (size_t)(r0 + (S - k)) * 1024 + cc;
                    *(u32x4*)dm = pk8(acc[0][bj][m][0], acc[0][bj][m][1]); *(u32x4*)(dm + FW) = pk8(-acc[1][bj][m][0], -acc[1][bj][m][1]); } } } }
    }
};
struct ProbX : ProbBase { static constexpr bool PERM = true;
    const bf16* US; const bf16* WINT; bf16* X; int K; size_t hstepA, hstepB;
    HD void init(const Ctx& C, int G_, int c_) { US = C.US(); WINT = C.p16(WS_WINT); X = C.X(); K = KU; G = G_; c = c_; hstepA = (size_t)128 * KROW * 2; hstepB = (size_t)128 * KU * 2; }
    HD unsigned offA(int R, int C) const { return (unsigned)(R * KROW) * 2u + (unsigned)C * 2u; }
    HD unsigned offB(int R, int C) const { return (unsigned)(R * KU) * 2u + (unsigned)C * 2u; }
    HD bool next(int i, Unit& u) const { long L = (long)i * G + c; constexpr int nm = NCH / 256; if (L >= (long)NG * nm) return false; L = xcd_remap(L, (long)NG * nm);
        u.z = (int)(L / nm); u.pm = (int)(L % nm); u.pn = 0;
        u.a = (const char*)US + ((size_t)(u.z * NCH + u.pm * 256) * KROW) * 2; u.b = (const char*)WINT + (size_t)u.z * 256 * KU * 2; return true; }
    HD void epi(const Acc& acc, const Unit& u, int wr, int wc, int fr, int fq) const {
        const int row0 = u.pm * 256 + wr * 64 + fr, col0 = wc * 32 + 8 * fq;
#pragma unroll
        ROWLOOP { bf16* rp = X + (size_t)(u.z * NCH + row0 + ai * 128 + m * 16) * 256 + col0;
#pragma unroll
            for (int bj = 0; bj < 2; ++bj) *(u32x4*)(rp + bj * 128) = pk8(acc[ai][bj][m][0], acc[ai][bj][m][1]); }
    }
};
struct ProbY : ProbBase { static constexpr bool PERM = true;
    const bf16* US; const bf16* MFT; bf16* Z; int K; size_t hstepA, hstepB;
    HD void init(const Ctx& C, int G_, int c_) { US = C.US(); MFT = C.p16(WS_MFT); Z = C.Z(); K = KROW; G = G_; c = c_; hstepA = (size_t)128 * KROW * 2; hstepB = (size_t)128 * KROW * 2; }
    HD unsigned offA(int R, int C) const { return (unsigned)(R * KROW) * 2u + (unsigned)C * 2u; }
    HD unsigned offB(int R, int C) const { return (unsigned)(R * KROW) * 2u + (unsigned)C * 2u; }
    HD bool next(int i, Unit& u) const { long L = (long)i * G + c; constexpr int nm = NCH / 256, per = nm * (KU / 256); if (L >= (long)NG * per) return false; L = xcd_remap(L, (long)NG * per);
        u.z = (int)(L / per); const int r = (int)(L % per); u.pm = r / (KU / 256); u.pn = r % (KU / 256);
        u.a = (const char*)US + ((size_t)(u.z * NCH + u.pm * 256) * KROW) * 2; u.b = (const char*)MFT + ((size_t)(u.z * KU + u.pn * 256) * KROW) * 2; return true; }
    HD void epi(const Acc& acc, const Unit& u, int wr, int wc, int fr, int fq) const {
        const int row0 = u.pm * 256 + wr * 64 + fr, col0 = u.pn * 256 + wc * 32 + 8 * fq;
#pragma unroll
        ROWLOOP { const int ch = row0 + ai * 128 + m * 16;
#pragma unroll
            for (int bj = 0; bj < 2; ++bj) { const int n0 = col0 + bj * 128, j = n0 >> 4, h0 = n0 & 15;
                f32x4 v0 = acc[ai][bj][m][0], v1 = acc[ai][bj][m][1];
#pragma unroll
                for (int q = 0; q < 4; ++q) { v0[q] = gelu_tanh(v0[q]); v1[q] = gelu_tanh(v1[q]); }
                *(u32x4*)(Z + ((size_t)u.z * T + ch * LCH + j) * GH + h0) = pk8(v0, v1); } }
    }
};

struct ProbGlu : ProbBase { static constexpr bool PERM = true; static constexpr size_t kstepA = (size_t)4 * T * GH * 2;
    const bf16* Z; const bf16* W; int K; size_t hstepA, hstepB; EpiGlu e;
    HD void init(const Ctx& C, int G_, int c_) { Z = C.Z(); W = C.p16(WS_WGLU); K = SW; G = G_; c = c_; hstepA = (size_t)128 * GH * 2; hstepB = (size_t)128 * SW * 2; e = EpiGlu{C.BRB()}; }
    HD unsigned offA(int R, int C) const { return (unsigned)(((C >> 4) * T + R) * GH + (C & 15)) * 2u; }
    HD unsigned offB(int R, int C) const { return (unsigned)(R * SW + C) * 2u; }
    HD bool next(int i, Unit& u) const { if (!pg8::static_order(T / 256, 2 * D / 256, G, c, i, u.pm, u.pn)) return false; u.z = 0;
        u.a = (const char*)Z + (size_t)u.pm * 2 * hstepA; u.b = (const char*)W + (size_t)u.pn * 2 * hstepB; return true; }
    HD void epi(const Acc& acc, const Unit& u, int wr, int wc, int fr, int fq) const { e(acc, u, wr, wc, fr, fq); }
};
HD float a1_entry(int r, int k) { const int ri = r >> 7, ka = r & 127; float c, s; cis_frac((long)ka * k, SHI, &c, &s); const float sc = 0.08838834764831845f; return (ri == 0 ? c : -s) * sc; }
HD float a2_entry(int r, int k, int SLO) { const int ro = r >> 7, kb = r & 127; if (kb >= SLO || k >= 2 * SLO) return 0.f; const int rin = k / SLO, sl = k % SLO; float c, s; cis_frac((long)kb * sl, SLO, &c, &s);
    const float sc = 1.0f / sqrtf((float)SLO); return (ro == rin ? c : (ro == 0 ? s : -s)) * sc; }

constexpr int N_DFT_ITEMS = 3 * 65536, N_TW_ITEMS = 128 * (SLP + SLS), N_LAML_ITEMS = NG * 2 * NST,
              N_WINT_ITEMS = NG * 2 * NST * LCH, N_TOEP_ITEMS = NG * LCH * GH * LCH;
HD void dft_item(const Ctx& C, int e) { const int w = e >> 16, r = (e >> 8) & 255, k = e & 255;
    if (w == 0) { if (k < SHI) C.p16(WS_A1)[r * SHI + k] = (bf16)f2bf(a1_entry(r, k)); }
    else if (w == 1) { if (k < 2 * SLP) C.p16(WS_A2P)[r * 2 * SLP + k] = (bf16)f2bf(a2_entry(r, k, SLP)); }
    else { if (k < 2 * SLS) C.p16(WS_A2S)[r * 2 * SLS + k] = (bf16)f2bf(a2_entry(r, k, SLS)); } }
HD void tw_item(const Ctx& C, int e) { const bool smp = e >= 128 * SLP; const int i = smp ? e - 128 * SLP : e, SLO = smp ? SLS : SLP, ka = i / SLO, sl = i % SLO;
    float c, s; cis_frac((long)ka * sl, (long)SHI * SLO, &c, &s); ((f32x2*)(C.ws + (smp ? WS_TWS : WS_TWP)))[i] = (f32x2){c, s}; }
HD void laml_item(const Ctx& C, int e) { const int p = e % NST, dir = (e / NST) & 1, g = e / (2 * NST); const SsmState s = ssm_state(C, dir, g, p); float pr, pi; ssm_pow(s, (float)LCH, pr, pi);
    ((f32x2*)(C.ws + WS_LAML))[(g * 2 + dir) * NST + p] = (f32x2){pr, pi}; }
HD void wint_item(const Ctx& C, int e) { const int i = e % LCH, p = (e / LCH) % NST, dir = (e / (LCH * NST)) & 1, g = e / (LCH * NST * 2);
    const SsmState s = ssm_state(C, dir, g, p); float pr, pi; ssm_pow(s, (float)(dir == 0 ? LCH - 1 - i : i), pr, pi);
    const float ur = pr * s.cr - pi * s.ci, ui = pr * s.ci + pi * s.cr;
    const float* br = C.in[I_BRE] + (size_t)((dir * NG + g) * NST + p) * GH; const float* bi = C.in[I_BIM] + (size_t)((dir * NG + g) * NST + p) * GH;
    float re[GH], im[GH];
#pragma unroll
    for (int q = 0; q < GH; ++q) { re[q] = ur * br[q] - ui * bi[q]; im[q] = ur * bi[q] + ui * br[q]; }
    bf16* d0 = C.p16(WS_WINT) + ((size_t)(g * 256 + dir * 128 + p * 2) * KU + i * GH);
    *(u32x4*)d0 = (u32x4){pk2(re[0], re[1]), pk2(re[2], re[3]), pk2(re[4], re[5]), pk2(re[6], re[7])}; *(u32x4*)(d0 + 8) = (u32x4){pk2(re[8], re[9]), pk2(re[10], re[11]), pk2(re[12], re[13]), pk2(re[14], re[15])};
    *(u32x4*)(d0 + KU) = (u32x4){pk2(im[0], im[1]), pk2(im[2], im[3]), pk2(im[4], im[5]), pk2(im[6], im[7])}; *(u32x4*)(d0 + KU + 8) = (u32x4){pk2(im[8], im[9]), pk2(im[10], im[11]), pk2(im[12], im[13]), pk2(im[14], im[15])}; }
HD void toep_item(const Ctx& C, int e) { const float* KT = C.p32(WS_KTAB); const float* dsk = C.in[I_DSK];
    const int i = e % LCH, h = (e / LCH) % GH, j = (e / (LCH * GH)) % LCH, g = e / (LCH * GH * LCH);
    float v[GH];
    if (i == j) { const float* kf = KT + ((size_t)((g * 2 + 0) * LCH + 0) * GH + h) * GH; const float* kb = KT + ((size_t)((g * 2 + 1) * LCH + 0) * GH + h) * GH;
#pragma unroll
        for (int q = 0; q < GH; ++q) v[q] = kf[q] + kb[q] + (q == h ? dsk[g * GH + h] : 0.f); }
    else { const int dir = i < j ? 0 : 1, dd = i < j ? j - i : i - j; const float* kk = KT + ((size_t)((g * 2 + dir) * LCH + dd) * GH + h) * GH;
#pragma unroll
        for (int q = 0; q < GH; ++q) v[q] = kk[q]; }
    bf16* dst = C.p16(WS_MFT) + ((size_t)(g * KU + j * GH + h) * KROW + i * GH);
    *(u32x4*)dst = (u32x4){pk2(v[0], v[1]), pk2(v[2], v[3]), pk2(v[4], v[5]), pk2(v[6], v[7])}; *(u32x4*)(dst + 8) = (u32x4){pk2(v[8], v[9]), pk2(v[10], v[11]), pk2(v[12], v[13]), pk2(v[14], v[15])}; }
constexpr int N_KTW_ITEMS = NG * 2 * (LCH / 4);
template <class TP> HD void ktw_phase1(const Ctx& C, int it, int lane, TP tab) { const int ddb = it % (LCH / 4), dir = (it / (LCH / 4)) & 1, g = it / (2 * (LCH / 4));
    const SsmState s = ssm_state(C, dir, g, lane);
#pragma unroll
    for (int j = 0; j < 4; ++j) { float pr, pi; ssm_pow(s, (float)(4 * ddb + j), pr, pi); tab[j * 64 + lane] = (f32x2){pr * s.cr - pi * s.ci, pr * s.ci + pi * s.cr}; } }
template <class TP> HD void ktw_phase2(const Ctx& C, int it, int lane, TP tab) { const int ddb = it % (LCH / 4), dir = (it / (LCH / 4)) & 1, g = it / (2 * (LCH / 4)); const int j = lane >> 4, h = lane & 15, dd = 4 * ddb + j;
    float acc[GH];
#pragma unroll
    for (int q = 0; q < GH; ++q) acc[q] = 0.f;
    const float* cre = C.in[I_CRE] + (size_t)((dir * NG + g) * GH + h) * NST; const float* cim = C.in[I_CIM] + (size_t)((dir * NG + g) * GH + h) * NST;
    for (int p = 0; p < NST; ++p) { const f32x2 u = tab[j * 64 + p]; const float cr = cre[p], ci = cim[p];
        const float tr = cr * u[0] - ci * u[1], ti = cr * u[1] + ci * u[0];
        const float* br = C.in[I_BRE] + (size_t)((dir * NG + g) * NST + p) * GH; const float* bi = C.in[I_BIM] + (size_t)((dir * NG + g) * NST + p) * GH;
#pragma unroll
        for (int q = 0; q < GH; ++q) acc[q] += tr * br[q] - ti * bi[q]; }
    float* dst = C.p32(WS_KTAB) + ((size_t)((g * 2 + dir) * LCH + dd) * GH + h) * GH;
#pragma unroll
    for (int q = 0; q < GH; q += 4) *(f32x4*)(dst + q) = (f32x4){acc[q], acc[q + 1], acc[q + 2], acc[q + 3]}; }
constexpr int N_MFS2_ITEMS = NG * LCH * 2 * 8;
HD void mfs2_item(const Ctx& C, int e) { const int pb = e % 8, dir = (e / 8) & 1, j = (e / 16) % LCH, g = e / (16 * LCH);
    float pr[8], pi[8];
#pragma unroll
    for (int q = 0; q < 8; ++q) { const SsmState s = ssm_state(C, dir, g, pb * 8 + q); ssm_pow(s, (float)(dir == 0 ? j + 1 : LCH - j), pr[q], pi[q]); }
    for (int h = 0; h < GH; ++h) { const float* cre = C.in[I_CRE] + (size_t)((dir * NG + g) * GH + h) * NST + pb * 8; const float* cim = C.in[I_CIM] + (size_t)((dir * NG + g) * GH + h) * NST + pb * 8;
        unsigned w[8];
#pragma unroll
        for (int q = 0; q < 8; ++q) w[q] = pk2(cre[q] * pr[q] - cim[q] * pi[q], -(cre[q] * pi[q] + cim[q] * pr[q]));
        bf16* dst = C.p16(WS_MFT) + ((size_t)(g * KU + j * GH + h) * KROW + KU + dir * 128 + pb * 16);
        *(u32x4*)dst = (u32x4){w[0], w[1], w[2], w[3]}; *(u32x4*)(dst + 8) = (u32x4){w[4], w[5], w[6], w[7]}; } }
struct TrItem { const float* W; int ldw; const float* gain; bf16* WT; int ldk, k0, n0, drow0; float cs; };
constexpr int TI_A = (D / 64) * (NA / 32), TI_F = (D / 64) * (FW / 32), TI_GL = (SW / 64) * (D / 32), TI_O = (D / 64) * (D / 32), TI_GU = (D / 64) * (FFH / 32), TI_DN = (FFH / 64) * (D / 32);
constexpr int N_TR_ITEMS = TI_A + TI_F + 2 * TI_GL + TI_O + 2 * TI_GU + TI_DN;
HD TrItem tr_decode(const Ctx& C, int it) { int r = it; TrItem t;
    if (r < TI_A) { const int nb = r % (NA / 32), kb = r / (NA / 32); const int n0 = 32 * nb, ng = n0 - SW, which = ng / D, j = ng % D;
        t = TrItem{C.in[I_WIN], FW + SW + 2 * D, C.in[I_NMPRE], C.p16(WS_WA), D, 64 * kb, FW + n0, n0 < SW ? n0 : SW + 256 * (j / 128) + 128 * which + (j % 128), n0 < SW ? 1.0f : -1.4426950408889634f}; return t; } r -= TI_A;
    if (r < TI_F) { const int nb = r % (FW / 32), kb = r / (FW / 32); t = TrItem{C.in[I_WIN], FW + SW + 2 * D, C.in[I_NMPRE], C.p16(WS_WF), D, 64 * kb, 32 * nb, 32 * nb, 1.0f}; return t; } r -= TI_F;
    if (r < 2 * TI_GL) { const int which = r / TI_GL; r %= TI_GL; const int nb = r % (D / 32), kb = r / (D / 32), n0 = 32 * nb;
        t = TrItem{C.in[which ? I_WGG : I_WGV], D, nullptr, C.p16(WS_WGLU), SW, 64 * kb, n0, 256 * (n0 / 128) + 128 * which + (n0 % 128), which ? -1.4426950408889634f : 1.0f}; return t; } r -= 2 * TI_GL;
    if (r < TI_O) { const int nb = r % (D / 32), kb = r / (D / 32); t = TrItem{C.in[I_WOUT], D, nullptr, C.p16(WS_WO), D, 64 * kb, 32 * nb, 32 * nb, 1.0f}; return t; } r -= TI_O;
    if (r < 2 * TI_GU) { const int which = r / TI_GU; r %= TI_GU; const int nb = r % (FFH / 32), kb = r / (FFH / 32), n0 = 32 * nb;
        t = TrItem{C.in[which ? I_WFU : I_WFG], FFH, C.in[I_NFPRE], C.p16(WS_WGU), D, 64 * kb, n0, 256 * (n0 / 128) + 128 * which + (n0 % 128), which ? -0.6931471805599453f : -1.4426950408889634f}; return t; } r -= 2 * TI_GU;
    { const int nb = r % (D / 32), kb = r / (D / 32); t = TrItem{C.in[I_WFD], D, nullptr, C.p16(WS_WDN), FFH, 64 * kb, 32 * nb, 32 * nb, 1.0f}; return t; } }

typedef GAS unsigned gu32;
#define LDS_WAIT() asm volatile("s_waitcnt lgkmcnt(0)" ::: "memory")
#define VM_WAIT() asm volatile("s_waitcnt vmcnt(0)" ::: "memory")
#define XB_TMO      128
#define XB_XCNT(j)  (256  + 64 * (j))
#define XB_XSUB(j)  (1280 + 64 * (j))
#define XB_XGEN(j)  (2304 + 64 * (j))
#define XB_TOP      3328
#define XB_TOPGEN   3392
#define XCD_BAR_WORDS 3456
#define XB_SPIN_CAP (1u << 22)
__device__ __forceinline__ unsigned xb_ld(unsigned* p)              { return __hip_atomic_load(p, __ATOMIC_RELAXED, __HIP_MEMORY_SCOPE_AGENT); }
__device__ __forceinline__ unsigned xb_add(unsigned* p, unsigned v) { return __hip_atomic_fetch_add(p, v, __ATOMIC_RELAXED, __HIP_MEMORY_SCOPE_AGENT); }
__device__ __forceinline__ unsigned xb_xcc_id() { return (unsigned)__builtin_amdgcn_s_getreg((3 << 11) | 20) & 0xFu; }
#define XB_SPIN(cond, bar) do { unsigned _sp = 0; while (cond) { __builtin_amdgcn_s_sleep(1); \
    if ((++_sp & 255u) == 0u) { if (xb_ld(&(bar)[XB_TMO])) break; if (_sp > XB_SPIN_CAP) { atomicAdd(&(bar)[XB_TMO], 1u); break; } } } } while (0)
struct XcdBarrier { unsigned* bar; unsigned x; volatile LAS unsigned* st; };
__device__ __forceinline__ XcdBarrier xcd_barrier_post(unsigned* bar, volatile LAS unsigned* st) {
    XcdBarrier b; b.bar = bar; b.x = xb_xcc_id(); b.st = st;
    if (threadIdx.x == 0) (void)xb_add(&bar[XB_XCNT(b.x)], 1u);
    return b;
}
__device__ __forceinline__ void xcd_barrier_complete(unsigned* bar, unsigned x, unsigned& nloc, unsigned& nx) {
    const unsigned G = gridDim.x * gridDim.y * gridDim.z;
    unsigned sum, cnt, mine, sp = 0u;
    for (;;) {
        sum = 0u; cnt = 0u; mine = 0u;
#pragma unroll
        for (unsigned j = 0; j < 16; ++j) { const unsigned c = xb_ld(&bar[XB_XCNT(j)]); sum += c; cnt += (c > 0u) ? 1u : 0u; mine = (j == x) ? c : mine; }
        if (sum == G) break;
        __builtin_amdgcn_s_sleep(1);
        if ((++sp & 255u) == 0u) { if (xb_ld(&bar[XB_TMO])) break; if (sp > XB_SPIN_CAP) { atomicAdd(&bar[XB_TMO], 1u); break; } }
    }
    nloc = mine > 0u ? mine : 1u; nx = cnt > 0u ? cnt : 1u;
}
__device__ __forceinline__ void xcd_barrier(const XcdBarrier& b) {
    asm volatile("s_waitcnt vmcnt(0)" ::: "memory");
    __syncthreads();
    if (threadIdx.x == 0) {
        unsigned* bar = b.bar;
        __builtin_amdgcn_s_waitcnt(0);
        unsigned nloc = b.st[0], nx = b.st[1];
        if (nloc == 0u) { xcd_barrier_complete(bar, b.x, nloc, nx); b.st[0] = nloc; b.st[1] = nx; }
        const unsigned old = xb_add(&bar[XB_XSUB(b.x)], 1u);
        const unsigned gen = old / nloc;
        if (old + 1u == (gen + 1u) * nloc) {
            __builtin_amdgcn_fence(__ATOMIC_RELEASE, "agent");
            asm volatile("s_waitcnt vmcnt(0)" ::: "memory");
            const unsigned og = xb_add(&bar[XB_TOP], 1u);
            const unsigned tg = og / nx;
            if (og + 1u == (tg + 1u) * nx) xb_add(&bar[XB_TOPGEN], 1u);
            else XB_SPIN(xb_ld(&bar[XB_TOPGEN]) == tg, bar);
            __builtin_amdgcn_fence(__ATOMIC_ACQUIRE, "agent");
            xb_add(&bar[XB_XGEN(b.x)], 1u);
            asm volatile("s_waitcnt vmcnt(0)" ::: "memory");
        } else {
            XB_SPIN(xb_ld(&bar[XB_XGEN(b.x)]) == gen, bar);
            __builtin_amdgcn_fence(__ATOMIC_ACQUIRE, "agent");
            asm volatile("s_waitcnt vmcnt(0)" ::: "memory");
        }
    }
    __syncthreads();
}

__device__ __forceinline__ float wave_sum(float v) {
#pragma unroll
    for (int o = 1; o < 64; o <<= 1) v += __shfl_xor(v, o);
    return v;
}
__device__ __forceinline__ void transpose_item(const float* W, int ldw, const float* gain, float cs, bf16* WT, int ldk, int k0, int n0, int drow0, LAS float* scr, int lane) {
#pragma unroll 8
    for (int i = 0; i < 32; ++i) { const int kk = 2 * i + (lane >> 5); const float gsc = (gain ? gain[k0 + kk] : 1.0f) * cs; scr[kk * 33 + (lane & 31)] = W[(size_t)(k0 + kk) * ldw + n0 + (lane & 31)] * gsc; }
    LDS_WAIT(); asm volatile("" ::: "memory");
    const int c = lane & 7;
#pragma unroll
    for (int j = 0; j < 4; ++j) { const int n = (lane >> 3) + 8 * j; const LAS float* s = scr + (8 * c) * 33 + n;
        u32x4 o; o.x = pk2(s[0 * 33], s[1 * 33]); o.y = pk2(s[2 * 33], s[3 * 33]); o.z = pk2(s[4 * 33], s[5 * 33]); o.w = pk2(s[6 * 33], s[7 * 33]);
        *(u32x4*)(WT + (size_t)(drow0 + n) * ldk + k0 + 8 * c) = o; }
    LDS_WAIT(); asm volatile("" ::: "memory");
}
constexpr int NV = D / 256;
__device__ __forceinline__ void ld_row_f32(const float* r, int lane, f32x4 (&v)[NV]) {
#pragma unroll
    for (int j = 0; j < NV; ++j) v[j] = *((const f32x4*)r + 64 * j + lane); }
__device__ __forceinline__ void ld_row_f32_nt(const float* r, int lane, f32x4 (&v)[NV]) {
#pragma unroll
    for (int j = 0; j < NV; ++j) v[j] = __builtin_nontemporal_load((const f32x4*)r + 64 * j + lane); }
__device__ __forceinline__ void ld_row_bf(const bf16* r, int lane, f32x4 (&v)[NV]) {
#pragma unroll
    for (int j = 0; j < NV; ++j) { const u32x2 w = *((const u32x2*)r + 64 * j + lane); v[j] = (f32x4){bf2f(w.x), bf2f(w.x >> 16), bf2f(w.y), bf2f(w.y >> 16)}; } }
__device__ __forceinline__ void ld_row_bf_nt(const bf16* r, int lane, f32x4 (&v)[NV]) {
#pragma unroll
    for (int j = 0; j < NV; ++j) { const u32x2 w = __builtin_nontemporal_load((const u32x2*)r + 64 * j + lane); v[j] = (f32x4){bf2f(w.x), bf2f(w.x >> 16), bf2f(w.y), bf2f(w.y >> 16)}; } }
__device__ __forceinline__ float row_sumsq(const f32x4 (&v)[NV]) { float s = 0.f;
#pragma unroll
    for (int j = 0; j < NV; ++j) s += (v[j][0] * v[j][0] + v[j][1] * v[j][1]) + (v[j][2] * v[j][2] + v[j][3] * v[j][3]);
    return wave_sum(s); }
__device__ __forceinline__ void st_row_bf(bf16* r, int lane, const f32x4 (&v)[NV], float sc) {
#pragma unroll
    for (int j = 0; j < NV; ++j) { u32x2 w; w.x = pk2(v[j][0] * sc, v[j][1] * sc); w.y = pk2(v[j][2] * sc, v[j][3] * sc); *((u32x2*)r + 64 * j + lane) = w; } }

__device__ __forceinline__ void p0_prologue(const Ctx& C, LAS unsigned char* lds, int bx, int G, int lane, int wave) {
    LAS float* scr = (LAS float*)(lds + wave * 16384);
    const int NGW = G * 8, vw = wave * G + bx;
    const int gt = vw * 64 + lane, NGT = NGW * 64;
    for (int it = vw; it < N_TR_ITEMS; it += NGW) { const TrItem t = tr_decode(C, it); transpose_item(t.W, t.ldw, t.gain, t.cs, t.WT, t.ldk, t.k0, t.n0, t.drow0, scr, lane); }
    {
        LAS f32x2* tab = (LAS f32x2*)scr;
        for (int t = lane; t < 128; t += 64) { float sn, cs; sincospi_((float)t / 64.0f, &sn, &cs); tab[t] = (f32x2){cs, sn}; }
        LDS_WAIT(); asm volatile("" ::: "memory");
        constexpr int NIT = 4 * (D / 8) * 2;
        const float* wfo = C.in[I_WFO]; bf16* WFO = C.p16(WS_WFO);
        for (int it = vw; it < NIT; it += NGW) { const int jh = it & 1, dblk = (it >> 1) % (D / 8), g = it / (2 * (D / 8)); const int d = dblk * 8 + (lane >> 3), j0 = jh * 64 + (lane & 7) * 8;
            float ac[8], as[8];
#pragma unroll
            for (int q = 0; q < 8; ++q) { ac[q] = 0.f; as[q] = 0.f; }
            for (int m0 = 0; m0 < 128; m0 += 8) { float w8[8];
#pragma unroll
                for (int mm = 0; mm < 8; ++mm) w8[mm] = wfo[(size_t)(128 * g + m0 + mm) * D + d];
#pragma unroll
                for (int mm = 0; mm < 8; ++mm) {
#pragma unroll
                    for (int q = 0; q < 8; ++q) { const f32x2 cs = tab[((m0 + mm) * (j0 + q)) & 127]; ac[q] += cs[0] * w8[mm]; as[q] += cs[1] * w8[mm]; } } }
            const float sc = 0.08838834764831845f;
            u32x4 wc_, ws_; wc_.x = pk2(ac[0] * sc, ac[1] * sc); wc_.y = pk2(ac[2] * sc, ac[3] * sc); wc_.z = pk2(ac[4] * sc, ac[5] * sc); wc_.w = pk2(ac[6] * sc, ac[7] * sc);
            ws_.x = pk2(as[0] * sc, as[1] * sc); ws_.y = pk2(as[2] * sc, as[3] * sc); ws_.z = pk2(as[4] * sc, as[5] * sc); ws_.w = pk2(as[6] * sc, as[7] * sc);
            bf16* rp = WFO + (size_t)d * (2 * FW) + 128 * g + j0;
            *(u32x4*)rp = wc_; *(u32x4*)(rp + FW) = ws_; }
        LDS_WAIT(); asm volatile("" ::: "memory");
    }
    for (int e = gt; e < N_DFT_ITEMS; e += NGT) dft_item(C, e);
    for (int e = gt; e < N_TW_ITEMS; e += NGT) tw_item(C, e);
    for (int e = gt; e < N_LAML_ITEMS; e += NGT) laml_item(C, e);
    { LAS f32x2* tab = (LAS f32x2*)scr;
      for (int it = (vw + NGW - 4 * G) % NGW; it < N_KTW_ITEMS; it += NGW) { ktw_phase1(C, it, lane, tab); LDS_WAIT(); asm volatile("" ::: "memory"); ktw_phase2(C, it, lane, tab); LDS_WAIT(); asm volatile("" ::: "memory"); } }
    for (int e = gt; e < N_WINT_ITEMS; e += NGT) wint_item(C, e);
    for (int e = ((vw + NGW - 6 * G) % NGW) * 64 + lane; e < N_MFS2_ITEMS; e += NGT) mfs2_item(C, e);
    for (int tt = vw; tt < T; tt += NGW) { const int t = T - 1 - tt; f32x4 v[NV]; ld_row_f32_nt(C.xrow(t), lane, v); const float ms0 = row_sumsq(v) * (1.0f / D) + EPS, rs = 1.0f / sqrtf(ms0); st_row_bf(C.XB() + (size_t)t * D, lane, v, rs); if (lane == 0) C.p32(WS_IR0)[t] = sqrtf(ms0); }
}
__device__ __forceinline__ void p1_toeplitz(const Ctx& C, int gt, int NGT) { for (int e = gt; e < N_TOEP_ITEMS; e += NGT) toep_item(C, e); }
template <int CS> __device__ __forceinline__ void scan_item(const Ctx& C, LAS unsigned char* lds, int it, int lane, int wave) {
    constexpr int CB = CS < 32 ? CS : 32, NB = CS / CB;
    const int dir = it & 1, g = (it >> 1) % NG, sq = it / (2 * NG);
    const int c0 = seq_start(sq) / LCH, nc = CS * 8;
    const f32x2 lam = ((const f32x2*)(C.ws + WS_LAML))[(g * 2 + dir) * NST + lane];
    const int k0 = wave * CS, chf = c0 + (dir == 0 ? k0 : nc - 1 - k0);
    const long xs = dir == 0 ? 256 : -256, us = dir == 0 ? KROW : -KROW;
    const bf16* xp0 = C.X() + (size_t)g * NCH * 256 + dir * 128 + lane * 2 + (size_t)chf * 256;
    bf16* up0 = C.US() + (size_t)g * NCH * KROW + KU + dir * 128 + lane * 2 + (size_t)chf * KROW;
    float sr = 0.f, si = 0.f;
    for (int b = 0; b < NB; ++b) { f32x2 xv[CB]; const bf16* xp = xp0 + (long)(b * CB) * xs;
#pragma unroll
        for (int q = 0; q < CB; ++q) { const unsigned w = *(const unsigned*)(xp + (long)q * xs); xv[q] = (f32x2){bf2f(w), bf2f(w >> 16)}; }
#pragma unroll
        for (int q = 0; q < CB; ++q) { const float nr = lam[0] * sr - lam[1] * si + xv[q][0], ni = lam[0] * si + lam[1] * sr + xv[q][1]; sr = nr; si = ni; } }
    LAS f32x2* ends = (LAS f32x2*)lds;
    ends[wave * 64 + lane] = (f32x2){sr, si};
    __syncthreads();
    float pr = lam[0], pi = lam[1];
#pragma unroll
    for (int t = 1; t < CS; t <<= 1) { const float nr = pr * pr - pi * pi, ni = 2.f * pr * pi; pr = nr; pi = ni; }
    float cr = 0.f, ci = 0.f;
    for (int w2 = 0; w2 < wave; ++w2) { const f32x2 e = ends[w2 * 64 + lane]; const float nr = pr * cr - pi * ci + e[0], ni = pr * ci + pi * cr + e[1]; cr = nr; ci = ni; }
    sr = cr; si = ci;
    for (int b = 0; b < NB; ++b) { f32x2 xv[CB]; const bf16* xp = xp0 + (long)(b * CB) * xs; bf16* up = up0 + (long)(b * CB) * us;
#pragma unroll
        for (int q = 0; q < CB; ++q) { const unsigned w = *(const unsigned*)(xp + (long)q * xs); xv[q] = (f32x2){bf2f(w), bf2f(w >> 16)}; }
#pragma unroll
        for (int q = 0; q < CB; ++q) { *(unsigned*)(up + (long)q * us) = pk2(sr, si);
            const float nr = lam[0] * sr - lam[1] * si + xv[q][0], ni = lam[0] * si + lam[1] * sr + xv[q][1]; sr = nr; si = ni; } }
    __syncthreads();
}
__device__ __forceinline__ void p3_scan(const Ctx& C, LAS unsigned char* lds, int bx, int G, int lane, int wave) {
    constexpr int CSP = SP / LCH / 8, CSS = SS / LCH / 8;
    static_assert((CSP & (CSP - 1)) == 0 && (CSS & (CSS - 1)) == 0 && CSP >= 1 && CSS >= 1, "scan segments");
    for (int it = bx; it < (NPB + 1) * NG * 2; it += G) { if (it / (2 * NG) < NPB) scan_item<CSP>(C, lds, it, lane, wave); else scan_item<CSS>(C, lds, it, lane, wave); }
}
__device__ __forceinline__ void p7_mid(const Ctx& C, int bx, int G, int lane, int wave) {
    f32x4 gp[NV]; ld_row_f32(C.in[I_NMPOST], lane, gp);
    for (int blk = bx; blk < T / 32; blk += G) {
#pragma unroll 1
        for (int r = 0; r < 4; ++r) { const int t = T - 1 - (blk * 32 + wave * 4 + r); f32x4 x[NV], mm[NV]; ld_row_bf_nt(C.XB() + (size_t)t * D, lane, x); ld_row_bf_nt(C.MB() + (size_t)t * D, lane, mm); const float r0 = C.p32(WS_IR0)[t];
            const float rm = 1.0f / sqrtf(row_sumsq(mm) * (1.0f / D) + EPS);
#pragma unroll
            for (int j = 0; j < NV; ++j) x[j] = x[j] * r0 + mm[j] * rm * gp[j];
            const float ms1 = row_sumsq(x) * (1.0f / D) + EPS, r1 = 1.0f / sqrtf(ms1);
            st_row_bf(C.X1B() + (size_t)t * D, lane, x, r1); if (lane == 0) C.p32(WS_IR1)[t] = sqrtf(ms1); } }
}
__device__ __forceinline__ void p10_final(const Ctx& C, int gw, int NGW, int lane) {
    f32x4 gf[NV]; ld_row_f32(C.in[I_NFPOST], lane, gf);
    for (int tt = gw; tt < T; tt += NGW) { const int t = T - 1 - tt; f32x4 x1[NV], ff[NV]; ld_row_bf_nt(C.X1B() + (size_t)t * D, lane, x1); ld_row_bf_nt(C.FB() + (size_t)t * D, lane, ff);
        const float ir1 = C.p32(WS_IR1)[t], rf = 1.0f / sqrtf(row_sumsq(ff) * (1.0f / D) + EPS);
        float* o = C.out + (size_t)t * D;
#pragma unroll
        for (int j = 0; j < NV; ++j) __builtin_nontemporal_store(x1[j] * ir1 + ff[j] * rf * gf[j], (f32x4*)o + 64 * j + lane); }
}
constexpr int NWAVES = 8, RING_BYTES = 131072, LDSCTL_OFF = RING_BYTES, MISC_OFF = LDSCTL_OFF + 320, LDS_BYTES = 147456;
constexpr int CW_BAR = 4096;
static_assert((CW_BAR + XCD_BAR_WORDS) * 4 <= (int)CTL_BYTES, "ctl");
struct Args { const float* in[22]; float* out; unsigned char* ws; };
#ifndef MK_SP2
#define MK_SP2 true
#endif
#ifndef MK_ALIGN
#define MK_ALIGN true
#endif
__global__ void __launch_bounds__(NWAVES * 64, 2) hyb_fwd(Args args) {
#if DEVCODE
    extern __shared__ __attribute__((aligned(16))) unsigned char lds_raw[];
    LAS unsigned char* lds = (LAS unsigned char*)lds_raw;
    volatile LAS unsigned* MISC = (volatile LAS unsigned*)(lds + MISC_OFF);
    const int tid = threadIdx.x, lane = tid & 63, wave = __builtin_amdgcn_readfirstlane(tid >> 6);
    const int G = gridDim.x, bx = blockIdx.x;
    Ctx C;
#pragma unroll
    for (int i = 0; i < 22; ++i) C.in[i] = args.in[i];
    C.out = args.out; C.ws = args.ws;
    for (int u = tid; u < (LDS_BYTES - LDSCTL_OFF) / 4; u += NWAVES * 64) ((LAS unsigned*)(lds + LDSCTL_OFF))[u] = 0u;
    __syncthreads();
    XcdBarrier bar = xcd_barrier_post((unsigned*)(C.ws + WS_CTL) + CW_BAR, MISC + 8);
    const int gw = bx * NWAVES + wave, NGW = G * NWAVES, gt = gw * 64 + lane, NGT = NGW * 64;
#define GRID_BAR() xcd_barrier(bar)
#define RUN(P) pg8::gemm_phase<decltype(P), MK_ALIGN, MK_SP2>(lds, P)
    p0_prologue(C, lds, bx, G, lane, wave);
    GRID_BAR();
    p1_toeplitz(C, gt, NGT);
    { ProbStd<EpiUs> P; P.init(C.XB(), D, C.p16(WS_WA), D, T, SW, D, G, bx); P.e = EpiUs{C.US()}; RUN(P); }
    { ProbUT P; P.init(C, 0, NPB, SP, G, bx); RUN(P); }
    { ProbUT P; P.init(C, TP, 1, SS, G, (bx + G / 2) % G); RUN(P); }
    GRID_BAR();
    if (G == 256 && P2_NXU % 256 != 0 && S1_NA > 0) { constexpr int rX = P2_NXU % 256, nl = 256 - rX; const int lc = bx - rX; const bool light = lc >= 0;
      { ProbS1 P; P.init(C, 0, S1_NA, SP, (const f32x2*)(C.ws + WS_TWP), 256, bx); RUN(P); }
      { ProbS1 P; P.init(C, S1_NA * SP, NPB - S1_NA, SP, (const f32x2*)(C.ws + WS_TWP), nl, light ? lc : (1 << 28)); RUN(P); }
      { ProbS1 P; P.init(C, TP, 1, SS, (const f32x2*)(C.ws + WS_TWS), nl, light ? (lc + nl - (S1_NB % nl)) % nl : (1 << 28)); RUN(P); }
    } else {
      { ProbS1 P; P.init(C, 0, NPB, SP, (const f32x2*)(C.ws + WS_TWP), G, bx); RUN(P); }
      { ProbS1 P; P.init(C, TP, 1, SS, (const f32x2*)(C.ws + WS_TWS), G, bx); RUN(P); } }
    { ProbX P; P.init(C, G, bx); RUN(P); }
    GRID_BAR();
    p3_scan(C, lds, bx, G, lane, wave);
    { ProbS2 P; P.init(C, 0, NPB, SP, C.p16(WS_A2P), G, bx); RUN(P); }
    { ProbS2 P; P.init(C, TP, 1, SS, C.p16(WS_A2S), G, (bx + G - (NPB * KAH * FW / 256) % G) % G); RUN(P); }
    GRID_BAR();
    { ProbY P; P.init(C, G, bx); RUN(P); }
    { ProbPQ P; P.init(C, G, (bx + G / 2) % G); RUN(P); }
    GRID_BAR();
    { ProbGlu P; P.init(C, G, bx); RUN(P); }
    GRID_BAR();
    { ProbStd<EpiGate> P; P.init(C.XB(), D, C.p16(WS_WA) + (size_t)SW * D, D, T, 2 * D, D, G, bx); P.e = EpiGate{C.PB(), C.QB(), C.BRB()}; RUN(P); }
    GRID_BAR();
    { ProbStd<EpiBf> P; P.init(C.BRB(), D, C.p16(WS_WO), D, T, D, D, G, bx); P.e = EpiBf{C.MB(), D}; RUN(P); }
    GRID_BAR();
    p7_mid(C, bx, G, lane, wave);
    GRID_BAR();
    { ProbStd<EpiFfn> P; P.init(C.X1B(), D, C.p16(WS_WGU), D, T, 2 * FFH, D, G, bx); P.e = EpiFfn{C.AB()}; RUN(P); }
    GRID_BAR();
    { ProbStd<EpiBf> P; P.init(C.AB(), FFH, C.p16(WS_WDN), FFH, T, D, FFH, G, bx); P.e = EpiBf{C.FB(), D}; RUN(P); }
    GRID_BAR();
    p10_final(C, gw, NGW, lane);
#endif
}

#ifndef HOST_EMU
extern "C" void kernel_launch(void* const* d_in, const int* in_sizes, int n_in, void* d_out, int out_size, void* d_ws, size_t ws_size, hipStream_t stream) {
    static int grid = 0;
    if (grid == 0) {
        if (n_in != 22 || out_size != T * D || ws_size < WS_END) { fprintf(stderr, "kernel_launch: unexpected shapes n_in %d out %d ws %zu (need %zu)\n", n_in, out_size, ws_size, (size_t)WS_END); grid = -1; return; }
        int dev = 0, cus = 0, per_cu = 0;
        if (hipGetDevice(&dev) != hipSuccess || hipDeviceGetAttribute(&cus, hipDeviceAttributeMultiprocessorCount, dev) != hipSuccess) { grid = -1; return; }
        if (hipFuncSetAttribute((const void*)hyb_fwd, hipFuncAttributeMaxDynamicSharedMemorySize, LDS_BYTES) != hipSuccess) { fprintf(stderr, "kernel_launch: hipFuncSetAttribute failed\n"); grid = -1; return; }
        if (hipOccupancyMaxActiveBlocksPerMultiprocessor(&per_cu, (const void*)hyb_fwd, 512, LDS_BYTES) != hipSuccess || per_cu < 1) fprintf(stderr, "kernel_launch: occupancy query says %d\n", per_cu);
        (void)hipGetLastError();
        grid = cus;
    }
    if (grid < 0) return;
    if (hipMemsetAsync((char*)d_ws + WS_CTL, 0, CTL_BYTES, stream) != hipSuccess) return;
    Args a{};
    for (int i = 0; i < 22; ++i) a.in[i] = (const float*)d_in[i];
    a.out = (float*)d_out; a.ws = (unsigned char*)d_ws;
    hipLaunchKernelGGL(hyb_fwd, dim3(grid), dim3(512), LDS_BYTES, stream, a);
}
#endif
```

```cpp
#include <hip/hip_runtime.h>
#include <cstdio>
#include <cstdint>
#include <cmath>

#ifndef CFG_D
#define CFG_D 1024
#endif
#ifndef CFG_FFH
#define CFG_FFH 2816
#endif
#ifndef CFG_NPB
#define CFG_NPB 8
#endif
#ifndef CFG_SP
#define CFG_SP 8192
#endif
#ifndef CFG_SS
#define CFG_SS 16384
#endif
#define HD __host__ __device__ __forceinline__

typedef unsigned short bf16;
typedef short bf16x8 __attribute__((ext_vector_type(8)));
typedef float f32x4 __attribute__((ext_vector_type(4)));
typedef float f32x2 __attribute__((ext_vector_type(2)));
typedef unsigned u32x4 __attribute__((ext_vector_type(4)));
typedef unsigned u32x2 __attribute__((ext_vector_type(2)));

constexpr int D = CFG_D, FFH = CFG_FFH, NPB = CFG_NPB, SP = CFG_SP, SS = CFG_SS;
constexpr int TP = NPB * SP, T = TP + SS;
constexpr int NRH = T / 2 + 256 * (NPB + 1);
constexpr int FW = 512, SW = 512, NG = 32, GH = 16, NST = 64;
constexpr int NA = SW + 2 * D;
constexpr int LCH = 32, NCH = T / LCH, KU = GH * LCH, KROW = KU + 256;
constexpr int SHI = 128, KAH = SHI / 2 + 1, SLP = SP / SHI, SLS = SS / SHI;
constexpr float EPS = 1e-6f;
static_assert(T % 8192 == 0 && D % 256 == 0 && FFH % 128 == 0 && (2 * FFH) % 256 == 0 && SP % 256 == 0 && SS % 256 == 0, "tile shapes");
static_assert(SLP >= 64 && SLP <= 128 && SLS >= 64 && SLS <= 128 && KU == 512, "dft split (K = 2*S_lo must be a multiple of 128)");

constexpr size_t al(size_t x) { return (x + 4095) & ~(size_t)4095; }
constexpr size_t WS_CTL = 0, CTL_BYTES = 65536;
constexpr size_t WS_WA = al(WS_CTL + CTL_BYTES);
constexpr size_t WS_WF = al(WS_WA + (size_t)NA * D * 2);
constexpr size_t WS_WGLU = al(WS_WF + (size_t)FW * D * 2);
constexpr size_t WS_WFO = al(WS_WGLU + (size_t)2 * D * SW * 2);
constexpr size_t WS_WO = al(WS_WFO + (size_t)D * 2 * FW * 2);
constexpr size_t WS_WGU = al(WS_WO + (size_t)D * D * 2);
constexpr size_t WS_WDN = al(WS_WGU + (size_t)2 * FFH * D * 2);
constexpr size_t WS_A1 = al(WS_WDN + (size_t)D * FFH * 2);
constexpr size_t WS_A2P = al(WS_A1 + 256 * 256 * 2);
constexpr size_t WS_A2S = al(WS_A2P + 256 * 256 * 2);
constexpr size_t WS_TWP = al(WS_A2S + 256 * 256 * 2);
constexpr size_t WS_TWS = al(WS_TWP + (size_t)128 * SLP * 8);
constexpr size_t WS_KTAB = al(WS_TWS + (size_t)128 * SLS * 8);
constexpr size_t WS_WINT = al(WS_KTAB + (size_t)NG * 2 * LCH * 256 * 4);
constexpr size_t WS_MFT = al(WS_WINT + (size_t)NG * 256 * KU * 2);
constexpr size_t WS_LAML = al(WS_MFT + (size_t)NG * KU * KROW * 2);
constexpr size_t WS_IR1 = al(WS_LAML + (size_t)NG * 2 * 64 * 8);
constexpr size_t WS_ACT = al(WS_IR1 + (size_t)T * 4 + (1u << 19));
constexpr size_t UB = (size_t)T * D * 2;
constexpr size_t WS_R0 = WS_ACT;
constexpr size_t WS_R1 = al(WS_R0 + ((size_t)T * 1024 * 2 > UB ? (size_t)T * 1024 * 2 : UB));
constexpr size_t WS_R2 = al(WS_R1 + UB);
constexpr size_t WS_R3 = al(WS_R2 + UB);
constexpr size_t WS_R4 = al(WS_R3 + (size_t)NG * NCH * KROW * 2);
constexpr size_t WS_R5 = al(WS_R4 + (size_t)T * 512 * 2);
constexpr size_t WS_R6 = al(WS_R5 + (size_t)T * 1024 * 2 + 4096);
constexpr size_t WS_END0 = al(WS_R6 + ((size_t)NG * NCH * 256 * 2 > (size_t)NRH * D * 2 ? (size_t)NG * NCH * 256 * 2 : (size_t)NRH * D * 2));
constexpr size_t WS_AEND = al(WS_R2 + (size_t)T * FFH * 2);
constexpr size_t WS_END = WS_END0 > WS_AEND ? WS_END0 : WS_AEND;
static_assert(CFG_D != 1024 || WS_END <= ((size_t)1 << 30), "d_ws map exceeds 1 GiB");
static_assert((size_t)NRH * D * 2 <= UB && NRH % 256 == 0, "P / Q half-spectrum products fit their regions");

#if defined(__HIP_DEVICE_COMPILE__)
#define DEVCODE 1
#else
#define DEVCODE 0
#endif

HD unsigned f2bf(float f) { unsigned u = __builtin_bit_cast(unsigned, f); return (u + 0x7fffu + ((u >> 16) & 1u)) >> 16; }
HD float bf2f(unsigned b) { return __builtin_bit_cast(float, (b & 0xffffu) << 16); }
typedef __bf16 bf16x2_t __attribute__((ext_vector_type(2)));
HD unsigned pk2(float lo, float hi) {
#if DEVCODE
    const f32x2 v = {lo, hi}; const bf16x2_t b = __builtin_convertvector(v, bf16x2_t); return __builtin_bit_cast(unsigned, b);
#else
    return f2bf(lo) | (f2bf(hi) << 16);
#endif
}
HD u32x4 pk8(f32x4 a, f32x4 b) { u32x4 w; w.x = pk2(a[0], a[1]); w.y = pk2(a[2], a[3]); w.z = pk2(b[0], b[1]); w.w = pk2(b[2], b[3]); return w; }
HD void unpk8(u32x4 w, f32x4& a, f32x4& b) {
    a[0] = bf2f(w.x); a[1] = bf2f(w.x >> 16); a[2] = bf2f(w.y); a[3] = bf2f(w.y >> 16);
    b[0] = bf2f(w.z); b[1] = bf2f(w.z >> 16); b[2] = bf2f(w.w); b[3] = bf2f(w.w >> 16);
}
HD float fexp(float x) {
#if DEVCODE
    return __expf(x);
#else
    return expf(x);
#endif
}
HD float frcp(float x) {
#if DEVCODE
    return __builtin_amdgcn_rcpf(x);
#else
    return 1.0f / x;
#endif
}
HD float sigm(float x) { return frcp(1.0f + fexp(-x)); }
HD float fexp2(float x) {
#if DEVCODE
    return __builtin_amdgcn_exp2f(x);
#else
    return exp2f(x);
#endif
}
HD float sigm_ps(float xs) { return frcp(1.0f + fexp2(xs)); }
HD float gelu_tanh(float x) { const float y = 0.7978845608f * (x + 0.044715f * x * x * x); return x * frcp(1.0f + fexp(-2.0f * y)); }
HD void sincospi_(float x, float* s, float* c) {
#if DEVCODE
    sincospif(x, s, c);
#else
    *s = (float)sin(3.14159265358979323846 * (double)x); *c = (float)cos(3.14159265358979323846 * (double)x);
#endif
}
HD void cis_frac(long num, long den, float* c, float* s) { const long r = num % den; sincospi_(2.0f * (float)r / (float)den, s, c); }

HD int seq_start(int s) { return s < NPB ? s * SP : TP; }
HD int go_row0(int s) { return seq_start(s) / 2 + 256 * s; }
HD int opaque_int(int v) {
#if DEVCODE
    asm volatile("" : "+s"(v));
#endif
    return v; }

struct Ctx {
    const float* in[22]; float* out; unsigned char* ws;
    HD bf16* p16(size_t off) const { return (bf16*)(ws + off); }
    HD float* p32(size_t off) const { return (float*)(ws + off); }
    HD bf16* GO() const { return p16(WS_R0); }  HD bf16* MB() const { return p16(WS_R0); }
    HD bf16* PB() const { return p16(WS_R1); }  HD bf16* X1B() const { return p16(WS_R1); } HD bf16* FB() const { return p16(WS_R0); }  HD bf16* QB() const { return p16(WS_R6); }
    HD bf16* XB() const { return p16(WS_R2); }  HD bf16* AB() const { return p16(WS_R2); }  HD bf16* BRB() const { return p16(WS_R5); }
    HD bf16* US() const { return p16(WS_R3); }
    HD bf16* UT() const { return p16(WS_R4); }  HD bf16* Z() const { return p16(WS_R4); }
    HD bf16* PP() const { return p16(WS_R5); }
    HD bf16* X() const { return p16(WS_R6); }
    HD const float* xrow(int t) const { return t < TP ? in[0] + (size_t)t * D : in[1] + (size_t)(t - TP) * D; }
};
enum { I_XP = 0, I_XS, I_NMPRE, I_NMPOST, I_NFPRE, I_NFPOST, I_WIN, I_WFO, I_LRE, I_LIM, I_LDT, I_BRE, I_BIM, I_CRE, I_CIM, I_DSK, I_WGV, I_WGG, I_WOUT, I_WFG, I_WFU, I_WFD };

struct SsmState { float are, aim, cr, ci; };
HD SsmState ssm_state(const Ctx& C, int dir, int g, int p) {
    const int i = (dir * NG + g) * NST + p;
    const float lre = C.in[I_LRE][i], lim = C.in[I_LIM][i], dt = expf(C.in[I_LDT][dir * NG + g]);
    SsmState s; s.are = lre * dt; s.aim = lim * dt;
    float sn, cs; sincosf(s.aim, &sn, &cs); float sh, ch; sincosf(0.5f * s.aim, &sh, &ch);
    const float em1 = expm1f(s.are), e = em1 + 1.0f;
    const float nr = em1 * cs - 2.0f * sh * sh, ni = e * sn;
    const float inv = 1.0f / (lre * lre + lim * lim);
    s.cr = (nr * lre + ni * lim) * inv; s.ci = (ni * lre - nr * lim) * inv;
    return s;
}
HD void ssm_pow(const SsmState& s, float e, float& pr, float& pi) { const float m = expf(e * s.are); float sn, cs; sincosf(e * s.aim, &sn, &cs); pr = m * cs; pi = m * sn; }

#define LAS __attribute__((address_space(3)))
#define GAS __attribute__((address_space(1)))
#ifndef MK_ZEROC
#define MK_ZEROC 1
#endif
namespace pg8 {
constexpr int BM = 256, BK = 64, HALF = 128, HTB = HALF * BK * 2, STAGE_BYTES = 8 * HTB, NXCD = 8, WGM = 8;
HD int lds_byte(int r, int c) { const int st = (r >> 4) * 2 + (c >> 5), rr = r & 15, cc = c & 31, ob = rr * 64 + cc * 2; return st * 1024 + (ob ^ (((ob >> 9) & 1) << 5)); }
HD void stage_rc(int b, int& R, int& C) { const int st = b / 1024, sb = b % 1024, swz = sb ^ (((sb >> 9) & 1) << 5); R = (st >> 1) * 16 + swz / 64; C = (st & 1) * 32 + (swz % 64) / 2; }
HD int perm32(int rho) { const int n = rho >> 4, i = rho & 15; return 8 * (i >> 2) + 4 * n + (i & 3); }
struct Unit { const char* a; const char* b; int pm, pn, z; };
typedef f32x4 Acc[2][2][4][2];
HD bool static_order(int nM, int nN, int G, int c, int i, int& pm, int& pn) {
    const int nwg = nM * nN; const long L = (long)i * G + c; if (L >= nwg) return false;
    int wgid = (int)L; { const int q = nwg / NXCD, r = nwg % NXCD, xcd = wgid % NXCD, off = wgid / NXCD; wgid = (xcd < r ? xcd * (q + 1) : r * (q + 1) + (xcd - r) * q) + off; }
    const int nig = WGM * nN, gid = wgid / nig, fm = gid * WGM, gsz = (nM - fm) < WGM ? (nM - fm) : WGM;
    pm = fm + ((wgid % nig) % gsz); pn = (wgid % nig) / gsz; return true;
}
__device__ __forceinline__ f32x4 zero4() { f32x2 z = {0.f, 0.f}, lo, hi; asm volatile("v_pk_mov_b32 %0, %1, %1" : "=v"(lo) : "v"(z)); asm volatile("v_pk_mov_b32 %0, %1, %1" : "=v"(hi) : "v"(z)); return (f32x4){lo[0], lo[1], hi[0], hi[1]}; }
template <class P, bool ALIGN_EPI, bool SP2>
__device__ __forceinline__ void gemm_phase(LAS unsigned char* lds, const P& p) {
    int tid = threadIdx.x; asm volatile("" : "+v"(tid));
    const int wid = __builtin_amdgcn_readfirstlane(tid >> 6), lane = tid & 63, wr = wid >> 2, wc = wid & 3, fr = lane & 15, fq = lane >> 4;
    const int nt = p.K / BK;
    unsigned voffA[2], voffB[2];
#pragma unroll
    for (int i = 0; i < 2; ++i) { int R, C; stage_rc(tid * 16 + i * 8192, R, C); const int Rb = P::PERM ? ((R & ~31) + perm32(R & 31)) : R;
        voffA[i] = p.offA(R, C); voffB[i] = p.offB(Rb, C); }
    const size_t kstepA = p.kstepA, kstepB = p.kstepB;
    const size_t hstepA = p.hstepA, hstepB = p.hstepB;
    const unsigned ldsw = (unsigned)wid * 1024u;
    const int aoff = lds_byte(wr * 64 + fr, fq * 8), boff = lds_byte(wc * 32 + fr, fq * 8);
#define PG8_SA(b, h) (((b) * 2 + (h)) * HTB)
#define PG8_SB(b, h) ((4 + (b) * 2 + (h)) * HTB)
#define PG8_STAGE(bufoff, gbase, voff) do { _Pragma("unroll") for (int _i = 0; _i < 2; ++_i) \
        __builtin_amdgcn_global_load_lds((const unsigned*)((const char*)(gbase) + (voff)[_i]), (LAS unsigned*)(lds + (bufoff) + ldsw + _i * 8192), 16, 0, 0); } while (0)
#define PG8_LDA(dst, b, h) do { _Pragma("unroll") for (int m = 0; m < 4; ++m) _Pragma("unroll") for (int k = 0; k < 2; ++k) dst[m][k] = *(const LAS bf16x8*)(lds + PG8_SA(b, h) + aoff + m * 2048 + k * 1024); } while (0)
#define PG8_LDB(dst, b, h) do { _Pragma("unroll") for (int n = 0; n < 2; ++n) _Pragma("unroll") for (int k = 0; k < 2; ++k) dst[n][k] = *(const LAS bf16x8*)(lds + PG8_SB(b, h) + boff + n * 2048 + k * 1024); } while (0)
#define PG8_MMA(ai, bj, At, Bt) do { __builtin_amdgcn_s_setprio(1); _Pragma("unroll") for (int m = 0; m < 4; ++m) _Pragma("unroll") for (int n = 0; n < 2; ++n) _Pragma("unroll") for (int k = 0; k < 2; ++k) \
        acc[ai][bj][m][n] = __builtin_amdgcn_mfma_f32_16x16x32_bf16(Bt[n][k], At[m][k], acc[ai][bj][m][n], 0, 0, 0); __builtin_amdgcn_s_setprio(0); } while (0)
#define PG8_MMAZ(ai, bj, At, Bt) do { __builtin_amdgcn_s_setprio(1); \
        _Pragma("unroll") for (int m = 0; m < 4; ++m) _Pragma("unroll") for (int n = 0; n < 2; ++n) asm volatile("v_mfma_f32_16x16x32_bf16 %0, %1, %2, 0" : "+v"(acc[ai][bj][m][n]) : "v"(Bt[n][0]), "v"(At[m][0])); \
        _Pragma("unroll") for (int m = 0; m < 4; ++m) _Pragma("unroll") for (int n = 0; n < 2; ++n) acc[ai][bj][m][n] = __builtin_amdgcn_mfma_f32_16x16x32_bf16(Bt[n][1], At[m][1], acc[ai][bj][m][n], 0, 0, 0); \
        __builtin_amdgcn_s_setprio(0); } while (0)
#define PG8_WAIT_V(n) asm volatile("s_waitcnt vmcnt(" #n ")" ::: "memory")
#define PG8_WAIT_L(n) asm volatile("s_waitcnt lgkmcnt(" #n ")" ::: "memory")
#define PG8_ITER(MM) do { \
            PG8_LDB(B0, 0, 0); PG8_LDB(B1, 0, 1); PG8_SCHED; PG8_LDA(At, 0, 0); PG8_STAGE(PG8_SA(1, 1), a1 + hstepA, voffA); \
            PG8_WAIT_V(8); PG8_WAIT_L(0); PG8_BAR; MM(0, 0, At, B0); MM(0, 1, At, B1); PG8_BAR; PG8_SCHED; \
            PG8_LDA(At, 0, 1); PG8_STAGE(PG8_SB(0, 0), b2, voffB); PG8_STAGE(PG8_SB(0, 1), b2 + hstepB, voffB); PG8_STAGE(PG8_SA(0, 0), a2, voffA); \
            PG8_WAIT_V(8); PG8_WAIT_L(0); PG8_BAR; MM(1, 0, At, B0); MM(1, 1, At, B1); PG8_BAR; PG8_SCHED; \
            PG8_LDB(B0, 1, 0); PG8_LDB(B1, 1, 1); PG8_SCHED; PG8_LDA(At, 1, 0); PG8_STAGE(PG8_SA(0, 1), a2 + hstepA, voffA); \
            PG8_WAIT_V(8); PG8_WAIT_L(0); PG8_BAR; PG8_MMA(0, 0, At, B0); PG8_MMA(0, 1, At, B1); PG8_BAR; PG8_SCHED; \
            PG8_LDA(At, 1, 1); PG8_STAGE(PG8_SB(1, 0), b3, voffB); PG8_STAGE(PG8_SB(1, 1), b3 + hstepB, voffB); PG8_STAGE(PG8_SA(1, 0), a3, voffA); \
            PG8_WAIT_V(8); PG8_WAIT_L(0); PG8_BAR; PG8_MMA(1, 0, At, B0); PG8_MMA(1, 1, At, B1); PG8_BAR; PG8_SCHED; } while (0)
#define PG8_BAR __builtin_amdgcn_s_barrier()
#define PG8_SCHED __builtin_amdgcn_sched_barrier(0)
    Unit cur, nxt; int ui = 0;
    if (!p.next(0, cur)) return;
    Acc acc;
    if constexpr (!(MK_ZEROC && SP2)) {
#pragma unroll
    for (int a = 0; a < 2; ++a)
#pragma unroll
        for (int b = 0; b < 2; ++b)
#pragma unroll
            for (int m = 0; m < 4; ++m)
#pragma unroll
                for (int n = 0; n < 2; ++n) acc[a][b][m][n] = zero4(); }
    bf16x8 At[4][2], B0[2][2], B1[2][2];
    const char* cA = cur.a; const char* cB = cur.b;
    if constexpr (SP2) {
        PG8_STAGE(PG8_SB(0, 0), cB, voffB); PG8_STAGE(PG8_SB(0, 1), cB + hstepB, voffB); PG8_STAGE(PG8_SA(0, 0), cA, voffA); PG8_STAGE(PG8_SA(0, 1), cA + hstepA, voffA);
        if (wr == 1) PG8_BAR;
        PG8_WAIT_V(2); PG8_BAR;
        PG8_STAGE(PG8_SB(1, 0), cB + kstepB, voffB); PG8_STAGE(PG8_SA(1, 0), cA + kstepA, voffA); PG8_STAGE(PG8_SB(1, 1), cB + hstepB + kstepB, voffB);
        PG8_WAIT_V(6); PG8_BAR;
    } else {
        PG8_STAGE(PG8_SB(0, 0), cB, voffB); PG8_STAGE(PG8_SA(0, 0), cA, voffA); PG8_STAGE(PG8_SB(0, 1), cB + hstepB, voffB); PG8_STAGE(PG8_SA(0, 1), cA + hstepA, voffA);
        if (wr == 1) PG8_BAR;
        PG8_WAIT_V(4); PG8_BAR;
        PG8_STAGE(PG8_SB(1, 0), cB + kstepB, voffB); PG8_STAGE(PG8_SA(1, 0), cA + kstepA, voffA); PG8_STAGE(PG8_SB(1, 1), cB + hstepB + kstepB, voffB);
        PG8_WAIT_V(6); PG8_BAR;
    }
    bool has_next = p.next(1, nxt);
    for (;;) {
        const char* nA = has_next ? nxt.a : cA; const char* nB = has_next ? nxt.b : cB;
#define PG8_PTRS(t) const bool last = ((t) == nt - 2); const char* a1 = cA + (size_t)((t) + 1) * kstepA; \
            const char* a2 = last ? nA : cA + (size_t)((t) + 2) * kstepA; const char* b2 = last ? nB : cB + (size_t)((t) + 2) * kstepB; const char* a3 = a2 + kstepA; const char* b3 = b2 + kstepB;
        if constexpr (MK_ZEROC && SP2) { PG8_PTRS(0); PG8_ITER(PG8_MMAZ); }
        for (int t = (MK_ZEROC && SP2) ? 2 : 0; t < nt; t += 2) {
            PG8_PTRS(t);
            if constexpr (SP2) {
            PG8_ITER(PG8_MMA);
            } else {
            PG8_LDB(B0, 0, 0); PG8_SCHED; PG8_LDA(At, 0, 0); PG8_STAGE(PG8_SA(1, 1), a1 + hstepA, voffA);
            PG8_WAIT_L(8); PG8_BAR; PG8_WAIT_L(0); PG8_MMA(0, 0, At, B0); PG8_BAR; PG8_SCHED;
            PG8_LDB(B1, 0, 1); PG8_STAGE(PG8_SB(0, 0), b2, voffB);
            PG8_BAR; PG8_WAIT_L(0); PG8_MMA(0, 1, At, B1); PG8_BAR;
            PG8_LDA(At, 0, 1); PG8_STAGE(PG8_SA(0, 0), a2, voffA);
            PG8_BAR; PG8_WAIT_L(0); PG8_MMA(1, 0, At, B0); PG8_BAR; PG8_SCHED;
            PG8_STAGE(PG8_SB(0, 1), b2 + hstepB, voffB);
            PG8_WAIT_V(6); PG8_BAR; PG8_MMA(1, 1, At, B1); PG8_BAR;
            PG8_LDB(B0, 1, 0); PG8_SCHED; PG8_LDA(At, 1, 0); PG8_STAGE(PG8_SA(0, 1), a2 + hstepA, voffA);
            PG8_WAIT_L(8); PG8_BAR; PG8_WAIT_L(0); PG8_MMA(0, 0, At, B0); PG8_BAR; PG8_SCHED;
            PG8_LDB(B1, 1, 1); PG8_STAGE(PG8_SB(1, 0), b3, voffB);
            PG8_BAR; PG8_WAIT_L(0); PG8_MMA(0, 1, At, B1); PG8_BAR;
            PG8_LDA(At, 1, 1); PG8_STAGE(PG8_SA(1, 0), a3, voffA);
            PG8_BAR; PG8_WAIT_L(0); PG8_MMA(1, 0, At, B0); PG8_BAR; PG8_SCHED;
            PG8_STAGE(PG8_SB(1, 1), b3 + hstepB, voffB);
            PG8_WAIT_V(6); PG8_BAR; PG8_MMA(1, 1, At, B1); PG8_BAR;
            }
        }
        if constexpr (ALIGN_EPI) { if (wr == 0) PG8_BAR; }
        Unit nn; const bool has_nn = p.next(ui + 2, nn);
        p.epi(acc, cur, wr, wc, fr, fq);
        if (!has_next) break;
        if constexpr (!(MK_ZEROC && SP2)) {
#pragma unroll
        for (int a = 0; a < 2; ++a)
#pragma unroll
            for (int b = 0; b < 2; ++b)
#pragma unroll
                for (int m = 0; m < 4; ++m)
#pragma unroll
                    for (int n = 0; n < 2; ++n) acc[a][b][m][n] = zero4(); }
        cur = nxt; cA = nA; cB = nB; ++ui; nxt = nn; has_next = has_nn;
        if constexpr (ALIGN_EPI) { if (wr == 1) PG8_BAR; }
    }
    PG8_WAIT_V(0);
    if constexpr (!ALIGN_EPI) { if (wr == 0) PG8_BAR; }
    PG8_BAR;
#undef PG8_SA
#undef PG8_SB
#undef PG8_STAGE
#undef PG8_LDA
#undef PG8_LDB
#undef PG8_MMA
#undef PG8_WAIT_V
#undef PG8_MMAZ
#undef PG8_ITER
#undef PG8_PTRS
#undef PG8_WAIT_L
#undef PG8_BAR
#undef PG8_SCHED
}
}
using pg8::Unit; using pg8::Acc;

HD long xcd_remap(long L, long n) { const long q = n / 8, r = n % 8, x = L % 8, off = L / 8; return (x < r ? x * (q + 1) : r * (q + 1) + (x - r) * q) + off; }
struct ProbBase { int G, c; static constexpr size_t kstepA = 128, kstepB = 128; };

template <class E> struct ProbStd : ProbBase {
    static constexpr bool PERM = E::PERM;
    const bf16* A; const bf16* Bt; int M, N, K, lda, ldb; size_t hstepA, hstepB; E e;
    HD void init(const bf16* A_, int lda_, const bf16* Bt_, int ldb_, int M_, int N_, int K_, int G_, int c_) { A = A_; Bt = Bt_; lda = lda_; ldb = ldb_; M = M_; N = N_; K = K_; G = G_; c = c_;
        hstepA = (size_t)128 * lda * 2; hstepB = (size_t)128 * ldb * 2; }
    HD unsigned offA(int R, int C) const { return (unsigned)(R * lda) * 2u + (unsigned)C * 2u; }
    HD unsigned offB(int R, int C) const { return (unsigned)(R * ldb) * 2u + (unsigned)C * 2u; }
    HD bool next(int i, Unit& u) const { if (!pg8::static_order(M / 256, N / 256, G, c, i, u.pm, u.pn)) return false; u.z = 0;
        u.a = (const char*)A + (size_t)u.pm * 2 * hstepA; u.b = (const char*)Bt + (size_t)u.pn * 2 * hstepB; return true; }
    HD void epi(const Acc& acc, const Unit& u, int wr, int wc, int fr, int fq) const { e(acc, u, wr, wc, fr, fq); }
};
#define ROWLOOP for (int am_ = 0; am_ < 8; ++am_) if (const int ai = am_ >> 2, m = am_ & 3; true)
struct EpiUs { static constexpr bool PERM = true; bf16* US;
    HD void operator()(const Acc& acc, const Unit& u, int wr, int wc, int fr, int fq) const {
        const int row0 = u.pm * 256 + wr * 64 + fr, col0 = u.pn * 256 + wc * 32 + 8 * fq;
#pragma unroll
        ROWLOOP { const int tok = row0 + ai * 128 + m * 16, ch = tok / LCH, j = tok % LCH;
#pragma unroll
            for (int bj = 0; bj < 2; ++bj) { const int cs = col0 + bj * 128, g = cs >> 4, h0 = cs & 15;
                *(u32x4*)(US + ((size_t)(g * NCH + ch) * KROW + j * GH + h0)) = pk8(acc[ai][bj][m][0], acc[ai][bj][m][1]); } }
    }
};
struct EpiBf { static constexpr bool PERM = true; bf16* O; int ldc;
    HD void operator()(const Acc& acc, const Unit& u, int wr, int wc, int fr, int fq) const {
        const int row0 = u.pm * 256 + wr * 64 + fr, col0 = u.pn * 256 + wc * 32 + 8 * fq;
#pragma unroll
        ROWLOOP { bf16* rp = O + (size_t)(row0 + ai * 128 + m * 16) * ldc + col0;
#pragma unroll
            for (int bj = 0; bj < 2; ++bj) *(u32x4*)(rp + bj * 128) = pk8(acc[ai][bj][m][0], acc[ai][bj][m][1]); }
    }
};
struct ProbPQ : ProbBase { static constexpr bool PERM = true;
    const bf16* GO; const bf16* W; bf16* PB; bf16* QB; int K; size_t hstepA, hstepB;
    HD void init(const Ctx& C, int G_, int c_) { GO = C.GO(); W = C.p16(WS_WFO); PB = C.PB(); QB = C.QB(); K = FW; G = G_; c = c_; hstepA = (size_t)128 * 2048; hstepB = (size_t)128 * 2048; }
    HD unsigned offA(int R, int C) const { return (unsigned)(R * 2048) + (unsigned)C * 2u; }
    HD unsigned offB(int R, int C) const { return (unsigned)(R * 2048) + (unsigned)C * 2u; }
    HD bool next(int i, Unit& u) const { int pm2; if (!pg8::static_order(2 * (NRH / 256), D / 256, G, c, i, pm2, u.pn)) return false; u.z = pm2 >= NRH / 256; u.pm = pm2 - u.z * (NRH / 256);
        u.a = (const char*)GO + (size_t)u.pm * 2 * hstepA + (size_t)u.z * FW * 2; u.b = (const char*)W + (size_t)u.pn * 2 * hstepB + (size_t)u.z * FW * 2; return true; }
    HD void epi(const Acc& acc, const Unit& u, int wr, int wc, int fr, int fq) const { EpiBf e{u.z ? QB : PB, D}; e(acc, u, wr, wc, fr, fq); }
};
struct EpiGlu { static constexpr bool PERM = true; bf16* BRB;
    HD void operator()(const Acc& acc, const Unit& u, int wr, int wc, int fr, int fq) const {
        const int row0 = u.pm * 256 + wr * 64 + fr, col0 = u.pn * 128 + wc * 32 + 8 * fq;
#pragma unroll
        ROWLOOP { const size_t o = (size_t)(row0 + ai * 128 + m * 16) * D + col0;
            f32x4 v0 = acc[ai][0][m][0], v1 = acc[ai][0][m][1]; const f32x4 t0 = acc[ai][1][m][0], t1 = acc[ai][1][m][1];
#pragma unroll
            for (int q = 0; q < 4; ++q) { v0[q] = v0[q] * sigm_ps(t0[q]); v1[q] = v1[q] * sigm_ps(t1[q]); }
            *(u32x4*)(BRB + o) = pk8(v0, v1); }
    }
};
struct EpiGate { static constexpr bool PERM = true; const bf16* PB; const bf16* QB; bf16* BRB;
    HD void operator()(const Acc& acc, const Unit& u, int wr, int wc, int fr, int fq) const {
        const int row0 = u.pm * 256 + wr * 64 + fr, col0 = u.pn * 128 + wc * 32 + 8 * fq;
#pragma unroll
        ROWLOOP { const int t = row0 + ai * 128 + m * 16, sq = t < TP ? t / SP : NPB, S = sq < NPB ? SP : SS, tl = t - seq_start(sq);
            const bool lowh = 2 * tl <= S; const size_t r = (size_t)(go_row0(sq) + (lowh ? tl : S - tl)) * D + col0, o = (size_t)t * D + col0;
            f32x4 p0, p1, q0, q1, b0, b1; unpk8(*(const u32x4*)(PB + r), p0, p1); unpk8(*(const u32x4*)(QB + r), q0, q1); unpk8(*(const u32x4*)(BRB + o), b0, b1);
            const f32x4 a0 = lowh ? p0 + q0 : p0 - q0, a1 = lowh ? p1 + q1 : p1 - q1;
            f32x4 v0 = acc[ai][0][m][0], v1 = acc[ai][0][m][1]; const f32x4 t0 = acc[ai][1][m][0], t1 = acc[ai][1][m][1];
#pragma unroll
            for (int q = 0; q < 4; ++q) { v0[q] = sigm_ps(v0[q]) * a0[q] + sigm_ps(t0[q]) * b0[q]; v1[q] = sigm_ps(v1[q]) * a1[q] + sigm_ps(t1[q]) * b1[q]; }
            *(u32x4*)(BRB + o) = pk8(v0, v1); }
    }
};
struct EpiFfn { static constexpr bool PERM = true; bf16* AB;
    HD void operator()(const Acc& acc, const Unit& u, int wr, int wc, int fr, int fq) const {
        const int row0 = u.pm * 256 + wr * 64 + fr, col0 = u.pn * 128 + wc * 32 + 8 * fq;
#pragma unroll
        ROWLOOP { const size_t o = (size_t)(row0 + ai * 128 + m * 16) * FFH + col0;
            f32x4 v0 = acc[ai][0][m][0], v1 = acc[ai][0][m][1]; const f32x4 t0 = acc[ai][1][m][0], t1 = acc[ai][1][m][1];
#pragma unroll
            for (int q = 0; q < 4; ++q) { v0[q] = v0[q] * t0[q] * sigm_ps(v0[q]); v1[q] = v1[q] * t1[q] * sigm_ps(v1[q]); }
            __builtin_nontemporal_store(pk8(v0, v1), (u32x4*)(AB + o)); }
    }
};

struct ProbUT : ProbBase { static constexpr bool PERM = true;
    const bf16* WF; const bf16* XB; bf16* UT; int t0, nseq, S, SLO, K; size_t hstepA, hstepB;
    HD void init(const Ctx& C, int t0_, int nseq_, int S_, int G_, int c_) { WF = C.p16(WS_WF); XB = C.XB(); UT = C.UT(); t0 = t0_; nseq = nseq_; S = S_; SLO = S_ / SHI; K = D; G = G_; c = c_;
        hstepA = (size_t)128 * D * 2; hstepB = (size_t)D * 2; }
    HD unsigned offA(int R, int C) const { return (unsigned)(R * D) * 2u + (unsigned)C * 2u; }
    HD unsigned offB(int R, int C) const { return (unsigned)R * (unsigned)(SLO * D * 2) + (unsigned)C * 2u; }
    HD bool next(int i, Unit& u) const { long L = (long)i * G + c; const int nt = S / 256; if (L >= (long)2 * nseq * nt) return false; L = xcd_remap(L, (long)2 * nseq * nt);
        u.pm = (int)(L & 1); const int q = (int)(L >> 1); u.z = q / nt; u.pn = q % nt;
        u.a = (const char*)WF + (size_t)u.pm * 2 * hstepA; u.b = (const char*)XB + ((size_t)(t0 + u.z * S + 2 * u.pn) * D) * 2; return true; }
    HD void epi(const Acc& acc, const Unit& u, int wr, int wc, int fr, int fq) const {
        const int row0 = u.pm * 256 + wr * 64 + fr, col0 = u.pn * 256 + wc * 32 + 8 * fq; bf16* base = UT + (size_t)(t0 + u.z * S) * FW;
#pragma unroll
        ROWLOOP { bf16* rp = base + (size_t)(row0 + ai * 128 + m * 16) * S + col0;
#pragma unroll
            for (int bj = 0; bj < 2; ++bj) *(u32x4*)(rp + bj * 128) = pk8(acc[ai][bj][m][0], acc[ai][bj][m][1]); }
    }
};
constexpr int P2_NXU = NG * (NCH / 256), S1_NA = NPB - (NPB + 3) / 4, S1_NB = (NPB - S1_NA) * FW * (SP / SHI) / 256;
struct ProbS1 : ProbBase { static constexpr bool PERM = true;
    const bf16* A1; const bf16* UT; bf16* PP; const f32x2* TW; int t0, nseq, S, SLO, K; size_t hstepA, hstepB;
    HD void init(const Ctx& C, int t0_, int nseq_, int S_, const f32x2* tw, int G_, int c_) { A1 = C.p16(WS_A1); UT = C.UT() + (size_t)t0_ * FW; PP = C.PP() + (t0_ < TP ? (size_t)(t0_ / SP) * KAH * FW * 2 * (SP / SHI) : (size_t)t0_ * 1024); TW = tw; t0 = t0_; nseq = nseq_; S = S_; SLO = S_ / SHI; K = opaque_int(128); G = G_; c = c_;
        hstepA = (size_t)128 * 128 * 2; hstepB = (size_t)128 * 128 * 2; }
    HD unsigned offA(int R, int C) const { return (unsigned)R * 256u + (unsigned)C * 2u; }
    HD unsigned offB(int R, int C) const { return (unsigned)R * 256u + (unsigned)C * 2u; }
    HD bool next(int i, Unit& u) const { const long L = (long)i * G + c; if (L >= (long)nseq * FW * SLO / 256) return false;
        u.pm = 0; u.pn = (int)L; u.z = 0; u.a = (const char*)A1; u.b = (const char*)UT + (size_t)L * 256 * 256; return true; }
    HD void epi(const Acc& acc, const Unit& u, int wr, int wc, int fr, int fq) const {
#pragma unroll
        for (int m = 0; m < 4; ++m) { const int ka = wr * 64 + m * 16 + fr; if (ka < KAH) {
#pragma unroll
            for (int bj = 0; bj < 2; ++bj) { const int q = u.pn * 256 + bj * 128 + wc * 32 + 8 * fq, sl = q % SLO, cc = (q / SLO) % FW, sq = q / (SLO * FW);
                const f32x4* tw = (const f32x4*)(TW + (size_t)ka * SLO + sl);
                f32x4 orr[2], oii[2];
#pragma unroll
                for (int n = 0; n < 2; ++n) { const f32x4 re = acc[0][bj][m][n], im = acc[1][bj][m][n]; const f32x4 ta = tw[2 * n], tb = tw[2 * n + 1];
                    const f32x4 cs = (f32x4){ta[0], ta[2], tb[0], tb[2]}, sn = (f32x4){ta[1], ta[3], tb[1], tb[3]};
                    orr[n] = re * cs + im * sn; oii[n] = im * cs - re * sn; }
                bf16* dst = PP + ((size_t)((sq * KAH + ka) * FW + cc) * 2) * SLO + sl;
                *(u32x4*)dst = pk8(orr[0], orr[1]); *(u32x4*)(dst + SLO) = pk8(oii[0], oii[1]); } } }
    }
};
struct ProbS2 : ProbBase { static constexpr bool PERM = true;
    const bf16* A2; const bf16* PP; bf16* GO; int t0, sq0, nseq, S, SLO, K; size_t hstepA, hstepB;
    HD void init(const Ctx& C, int t0_, int nseq_, int S_, const bf16* a2, int G_, int c_) { A2 = a2; PP = C.PP() + (size_t)t0_ * 1024; GO = C.GO(); t0 = t0_; sq0 = t0_ < TP ? t0_ / SP : NPB; nseq = nseq_; S = S_; SLO = S_ / SHI; K = opaque_int(2 * SLO); G = G_; c = c_;
        hstepA = (size_t)128 * 2 * SLO * 2; hstepB = (size_t)128 * 2 * SLO * 2; }
    HD unsigned offA(int R, int C) const { return (unsigned)(R * 2 * SLO) * 2u + (unsigned)C * 2u; }
    HD unsigned offB(int R, int C) const { return (unsigned)(R * 2 * SLO) * 2u + (unsigned)C * 2u; }
    HD bool next(int i, Unit& u) const { const long L = (long)i * G + c; if (L >= (long)nseq * KAH * FW / 256) return false;
        u.pm = 0; u.pn = (int)L; u.z = 0; u.a = (const char*)A2; u.b = (const char*)PP + (size_t)L * 2 * hstepB; return true; }
    HD void epi(const Acc& acc, const Unit& u, int wr, int wc, int fr, int fq) const {
#pragma unroll
        for (int m = 0; m < 4; ++m) { const int kb = wr * 64 + m * 16 + fr; if (kb < SLO) {
#pragma unroll
            for (int bj = 0; bj < 2; ++bj) { const int q = u.pn * 256 + bj * 128 + wc * 32 + 8 * fq, cc = q % FW, ka = (q / FW) % KAH, sq = q / (FW * KAH);
                const int k = ka + SHI * kb, r0 = go_row0(sq0 + sq);
                if (2 * k <= S) { bf16* dst = GO + (size_t)(r0 + k) * 1024 + cc;
                    *(u32x4*)dst = pk8(acc[0][bj][m][0], acc[0][bj][m][1]); *(u32x4*)(dst + FW) = pk8(acc[1][bj][m][0], acc[1][bj][m][1]); }
                else if (ka > 0 && ka < SHI / 2) { bf16* dm = GO + (size_t)(r0 + (S - k)) * 1024 + cc;
                    *(u32x4*)dm = pk8(acc[0][bj][m][0], acc[0][bj][m][1]); *(u32x4*)(dm + FW) = pk8(-acc[1][bj][m][0], -acc[1][bj][m][1]); } } } }
    }
};
struct ProbX : ProbBase { static constexpr bool PERM = true;
    const bf16* US; const bf16* WINT; bf16* X; int K; size_t hstepA, hstepB;
    HD void init(const Ctx& C, int G_, int c_) { US = C.US(); WINT = C.p16(WS_WINT); X = C.X(); K = KU; G = G_; c = c_; hstepA = (size_t)128 * KROW * 2; hstepB = (size_t)128 * KU * 2; }
    HD unsigned offA(int R, int C) const { return (unsigned)(R * KROW) * 2u + (unsigned)C * 2u; }
    HD unsigned offB(int R, int C) const { return (unsigned)(R * KU) * 2u + (unsigned)C * 2u; }
    HD bool next(int i, Unit& u) const { long L = (long)i * G + c; constexpr int nm = NCH / 256; if (L >= (long)NG * nm) return false; L = xcd_remap(L, (long)NG * nm);
        u.z = (int)(L / nm); u.pm = (int)(L % nm); u.pn = 0;
        u.a = (const char*)US + ((size_t)(u.z * NCH + u.pm * 256) * KROW) * 2; u.b = (const char*)WINT + (size_t)u.z * 256 * KU * 2; return true; }
    HD void epi(const Acc& acc, const Unit& u, int wr, int wc, int fr, int fq) const {
        const int row0 = u.pm * 256 + wr * 64 + fr, col0 = wc * 32 + 8 * fq;
#pragma unroll
        ROWLOOP { bf16* rp = X + (size_t)(u.z * NCH + row0 + ai * 128 + m * 16) * 256 + col0;
#pragma unroll
            for (int bj = 0; bj < 2; ++bj) *(u32x4*)(rp + bj * 128) = pk8(acc[ai][bj][m][0], acc[ai][bj][m][1]); }
    }
};
struct ProbY : ProbBase { static constexpr bool PERM = true;
    const bf16* US; const bf16* MFT; bf16* Z; int K; size_t hstepA, hstepB;
    HD void init(const Ctx& C, int G_, int c_) { US = C.US(); MFT = C.p16(WS_MFT); Z = C.Z(); K = KROW; G = G_; c = c_; hstepA = (size_t)128 * KROW * 2; hstepB = (size_t)128 * KROW * 2; }
    HD unsigned offA(int R, int C) const { return (unsigned)(R * KROW) * 2u + (unsigned)C * 2u; }
    HD unsigned offB(int R, int C) const { return (unsigned)(R * KROW) * 2u + (unsigned)C * 2u; }
    HD bool next(int i, Unit& u) const { long L = (long)i * G + c; constexpr int nm = NCH / 256, per = nm * (KU / 256); if (L >= (long)NG * per) return false; L = xcd_remap(L, (long)NG * per);
        u.z = (int)(L / per); const int r = (int)(L % per); u.pm = r / (KU / 256); u.pn = r % (KU / 256);
        u.a = (const char*)US + ((size_t)(u.z * NCH + u.pm * 256) * KROW) * 2; u.b = (const char*)MFT + ((size_t)(u.z * KU + u.pn * 256) * KROW) * 2; return true; }
    HD void epi(const Acc& acc, const Unit& u, int wr, int wc, int fr, int fq) const {
        const int row0 = u.pm * 256 + wr * 64 + fr, col0 = u.pn * 256 + wc * 32 + 8 * fq;
#pragma unroll
        ROWLOOP { const int ch = row0 + ai * 128 + m * 16;
#pragma unroll
            for (int bj = 0; bj < 2; ++bj) { const int n0 = col0 + bj * 128, j = n0 >> 4, h0 = n0 & 15;
                f32x4 v0 = acc[ai][bj][m][0], v1 = acc[ai][bj][m][1];
#pragma unroll
                for (int q = 0; q < 4; ++q) { v0[q] = gelu_tanh(v0[q]); v1[q] = gelu_tanh(v1[q]); }
                *(u32x4*)(Z + ((size_t)u.z * T + ch * LCH + j) * GH + h0) = pk8(v0, v1); } }
    }
};

struct ProbGlu : ProbBase { static constexpr bool PERM = true; static constexpr size_t kstepA = (size_t)4 * T * GH * 2;
    const bf16* Z; const bf16* W; int K; size_t hstepA, hstepB; EpiGlu e;
    HD void init(const Ctx& C, int G_, int c_) { Z = C.Z(); W = C.p16(WS_WGLU); K = SW; G = G_; c = c_; hstepA = (size_t)128 * GH * 2; hstepB = (size_t)128 * SW * 2; e = EpiGlu{C.BRB()}; }
    HD unsigned offA(int R, int C) const { return (unsigned)(((C >> 4) * T + R) * GH + (C & 15)) * 2u; }
    HD unsigned offB(int R, int C) const { return (unsigned)(R * SW + C) * 2u; }
    HD bool next(int i, Unit& u) const { if (!pg8::static_order(T / 256, 2 * D / 256, G, c, i, u.pm, u.pn)) return false; u.z = 0;
        u.a = (const char*)Z + (size_t)u.pm * 2 * hstepA; u.b = (const char*)W + (size_t)u.pn * 2 * hstepB; return true; }
    HD void epi(const Acc& acc, const Unit& u, int wr, int wc, int fr, int fq) const { e(acc, u, wr, wc, fr, fq); }
};
HD float a1_entry(int r, int k) { const int ri = r >> 7, ka = r & 127; float c, s; cis_frac((long)ka * k, SHI, &c, &s); const float sc = 0.08838834764831845f; return (ri == 0 ? c : -s) * sc; }
HD float a2_entry(int r, int k, int SLO) { const int ro = r >> 7, kb = r & 127; if (kb >= SLO || k >= 2 * SLO) return 0.f; const int rin = k / SLO, sl = k % SLO; float c, s; cis_frac((long)kb * sl, SLO, &c, &s);
    const float sc = 1.0f / sqrtf((float)SLO); return (ro == rin ? c : (ro == 0 ? s : -s)) * sc; }

constexpr int N_DFT_ITEMS = 3 * 65536, N_TW_ITEMS = 128 * (SLP + SLS), N_LAML_ITEMS = NG * 2 * NST,
              N_WINT_ITEMS = NG * 2 * NST * LCH, N_TOEP_ITEMS = NG * LCH * GH * LCH;
HD void dft_item(const Ctx& C, int e) { const int w = e >> 16, r = (e >> 8) & 255, k = e & 255;
    if (w == 0) { if (k < SHI) C.p16(WS_A1)[r * SHI + k] = (bf16)f2bf(a1_entry(r, k)); }
    else if (w == 1) { if (k < 2 * SLP) C.p16(WS_A2P)[r * 2 * SLP + k] = (bf16)f2bf(a2_entry(r, k, SLP)); }
    else { if (k < 2 * SLS) C.p16(WS_A2S)[r * 2 * SLS + k] = (bf16)f2bf(a2_entry(r, k, SLS)); } }
HD void tw_item(const Ctx& C, int e) { const bool smp = e >= 128 * SLP; const int i = smp ? e - 128 * SLP : e, SLO = smp ? SLS : SLP, ka = i / SLO, sl = i % SLO;
    float c, s; cis_frac((long)ka * sl, (long)SHI * SLO, &c, &s); ((f32x2*)(C.ws + (smp ? WS_TWS : WS_TWP)))[i] = (f32x2){c, s}; }
HD void laml_item(const Ctx& C, int e) { const int p = e % NST, dir = (e / NST) & 1, g = e / (2 * NST); const SsmState s = ssm_state(C, dir, g, p); float pr, pi; ssm_pow(s, (float)LCH, pr, pi);
    ((f32x2*)(C.ws + WS_LAML))[(g * 2 + dir) * NST + p] = (f32x2){pr, pi}; }
HD void wint_item(const Ctx& C, int e) { const int i = e % LCH, p = (e / LCH) % NST, dir = (e / (LCH * NST)) & 1, g = e / (LCH * NST * 2);
    const SsmState s = ssm_state(C, dir, g, p); float pr, pi; ssm_pow(s, (float)(dir == 0 ? LCH - 1 - i : i), pr, pi);
    const float ur = pr * s.cr - pi * s.ci, ui = pr * s.ci + pi * s.cr;
    const float* br = C.in[I_BRE] + (size_t)((dir * NG + g) * NST + p) * GH; const float* bi = C.in[I_BIM] + (size_t)((dir * NG + g) * NST + p) * GH;
    float re[GH], im[GH];
#pragma unroll
    for (int q = 0; q < GH; ++q) { re[q] = ur * br[q] - ui * bi[q]; im[q] = ur * bi[q] + ui * br[q]; }
    bf16* d0 = C.p16(WS_WINT) + ((size_t)(g * 256 + dir * 128 + p * 2) * KU + i * GH);
    *(u32x4*)d0 = (u32x4){pk2(re[0], re[1]), pk2(re[2], re[3]), pk2(re[4], re[5]), pk2(re[6], re[7])}; *(u32x4*)(d0 + 8) = (u32x4){pk2(re[8], re[9]), pk2(re[10], re[11]), pk2(re[12], re[13]), pk2(re[14], re[15])};
    *(u32x4*)(d0 + KU) = (u32x4){pk2(im[0], im[1]), pk2(im[2], im[3]), pk2(im[4], im[5]), pk2(im[6], im[7])}; *(u32x4*)(d0 + KU + 8) = (u32x4){pk2(im[8], im[9]), pk2(im[10], im[11]), pk2(im[12], im[13]), pk2(im[14], im[15])}; }
HD void toep_item(const Ctx& C, int e) { const float* KT = C.p32(WS_KTAB); const float* dsk = C.in[I_DSK];
    const int i = e % LCH, h = (e / LCH) % GH, j = (e / (LCH * GH)) % LCH, g = e / (LCH * GH * LCH);
    float v[GH];
    if (i == j) { const float* kf = KT + ((size_t)((g * 2 + 0) * LCH + 0) * GH + h) * GH; const float* kb = KT + ((size_t)((g * 2 + 1) * LCH + 0) * GH + h) * GH;
#pragma unroll
        for (int q = 0; q < GH; ++q) v[q] = kf[q] + kb[q] + (q == h ? dsk[g * GH + h] : 0.f); }
    else { const int dir = i < j ? 0 : 1, dd = i < j ? j - i : i - j; const float* kk = KT + ((size_t)((g * 2 + dir) * LCH + dd) * GH + h) * GH;
#pragma unroll
        for (int q = 0; q < GH; ++q) v[q] = kk[q]; }
    bf16* dst = C.p16(WS_MFT) + ((size_t)(g * KU + j * GH + h) * KROW + i * GH);
    *(u32x4*)dst = (u32x4){pk2(v[0], v[1]), pk2(v[2], v[3]), pk2(v[4], v[5]), pk2(v[6], v[7])}; *(u32x4*)(dst + 8) = (u32x4){pk2(v[8], v[9]), pk2(v[10], v[11]), pk2(v[12], v[13]), pk2(v[14], v[15])}; }
constexpr int N_KTW_ITEMS = NG * 2 * (LCH / 4);
template <class TP> HD void ktw_phase1(const Ctx& C, int it, int lane, TP tab) { const int ddb = it % (LCH / 4), dir = (it / (LCH / 4)) & 1, g = it / (2 * (LCH / 4));
    const SsmState s = ssm_state(C, dir, g, lane);
#pragma unroll
    for (int j = 0; j < 4; ++j) { float pr, pi; ssm_pow(s, (float)(4 * ddb + j), pr, pi); tab[j * 64 + lane] = (f32x2){pr * s.cr - pi * s.ci, pr * s.ci + pi * s.cr}; } }
template <class TP> HD void ktw_phase2(const Ctx& C, int it, int lane, TP tab) { const int ddb = it % (LCH / 4), dir = (it / (LCH / 4)) & 1, g = it / (2 * (LCH / 4)); const int j = lane >> 4, h = lane & 15, dd = 4 * ddb + j;
    float acc[GH];
#pragma unroll
    for (int q = 0; q < GH; ++q) acc[q] = 0.f;
    const float* cre = C.in[I_CRE] + (size_t)((dir * NG + g) * GH + h) * NST; const float* cim = C.in[I_CIM] + (size_t)((dir * NG + g) * GH + h) * NST;
    for (int p = 0; p < NST; ++p) { const f32x2 u = tab[j * 64 + p]; const float cr = cre[p], ci = cim[p];
        const float tr = cr * u[0] - ci * u[1], ti = cr * u[1] + ci * u[0];
        const float* br = C.in[I_BRE] + (size_t)((dir * NG + g) * NST + p) * GH; const float* bi = C.in[I_BIM] + (size_t)((dir * NG + g) * NST + p) * GH;
#pragma unroll
        for (int q = 0; q < GH; ++q) acc[q] += tr * br[q] - ti * bi[q]; }
    float* dst = C.p32(WS_KTAB) + ((size_t)((g * 2 + dir) * LCH + dd) * GH + h) * GH;
#pragma unroll
    for (int q = 0; q < GH; q += 4) *(f32x4*)(dst + q) = (f32x4){acc[q], acc[q + 1], acc[q + 2], acc[q + 3]}; }
constexpr int N_MFS2_ITEMS = NG * LCH * 2 * 8;
HD void mfs2_item(const Ctx& C, int e) { const int pb = e % 8, dir = (e / 8) & 1, j = (e / 16) % LCH, g = e / (16 * LCH);
    float pr[8], pi[8];
#pragma unroll
    for (int q = 0; q < 8; ++q) { const SsmState s = ssm_state(C, dir, g, pb * 8 + q); ssm_pow(s, (float)(dir == 0 ? j + 1 : LCH - j), pr[q], pi[q]); }
    for (int h = 0; h < GH; ++h) { const float* cre = C.in[I_CRE] + (size_t)((dir * NG + g) * GH + h) * NST + pb * 8; const float* cim = C.in[I_CIM] + (size_t)((dir * NG + g) * GH + h) * NST + pb * 8;
        unsigned w[8];
#pragma unroll
        for (int q = 0; q < 8; ++q) w[q] = pk2(cre[q] * pr[q] - cim[q] * pi[q], -(cre[q] * pi[q] + cim[q] * pr[q]));
        bf16* dst = C.p16(WS_MFT) + ((size_t)(g * KU + j * GH + h) * KROW + KU + dir * 128 + pb * 16);
        *(u32x4*)dst = (u32x4){w[0], w[1], w[2], w[3]}; *(u32x4*)(dst + 8) = (u32x4){w[4], w[5], w[6], w[7]}; } }
struct TrItem { const float* W; int ldw; const float* gain; bf16* WT; int ldk, k0, n0, drow0; float cs; };
constexpr int TI_A = (D / 64) * (NA / 32), TI_F = (D / 64) * (FW / 32), TI_GL = (SW / 64) * (D / 32), TI_O = (D / 64) * (D / 32), TI_GU = (D / 64) * (FFH / 32), TI_DN = (FFH / 64) * (D / 32);
constexpr int N_TR_ITEMS = TI_A + TI_F + 2 * TI_GL + TI_O + 2 * TI_GU + TI_DN;
HD TrItem tr_decode(const Ctx& C, int it) { int r = it; TrItem t;
    if (r < TI_A) { const int nb = r % (NA / 32), kb = r / (NA / 32); const int n0 = 32 * nb, ng = n0 - SW, which = ng / D, j = ng % D;
        t = TrItem{C.in[I_WIN], FW + SW + 2 * D, C.in[I_NMPRE], C.p16(WS_WA), D, 64 * kb, FW + n0, n0 < SW ? n0 : SW + 256 * (j / 128) + 128 * which + (j % 128), n0 < SW ? 1.0f : -1.4426950408889634f}; return t; } r -= TI_A;
    if (r < TI_F) { const int nb = r % (FW / 32), kb = r / (FW / 32); t = TrItem{C.in[I_WIN], FW + SW + 2 * D, C.in[I_NMPRE], C.p16(WS_WF), D, 64 * kb, 32 * nb, 32 * nb, 1.0f}; return t; } r -= TI_F;
    if (r < 2 * TI_GL) { const int which = r / TI_GL; r %= TI_GL; const int nb = r % (D / 32), kb = r / (D / 32), n0 = 32 * nb;
        t = TrItem{C.in[which ? I_WGG : I_WGV], D, nullptr, C.p16(WS_WGLU), SW, 64 * kb, n0, 256 * (n0 / 128) + 128 * which + (n0 % 128), which ? -1.4426950408889634f : 1.0f}; return t; } r -= 2 * TI_GL;
    if (r < TI_O) { const int nb = r % (D / 32), kb = r / (D / 32); t = TrItem{C.in[I_WOUT], D, nullptr, C.p16(WS_WO), D, 64 * kb, 32 * nb, 32 * nb, 1.0f}; return t; } r -= TI_O;
    if (r < 2 * TI_GU) { const int which = r / TI_GU; r %= TI_GU; const int nb = r % (FFH / 32), kb = r / (FFH / 32), n0 = 32 * nb;
        t = TrItem{C.in[which ? I_WFU : I_WFG], FFH, C.in[I_NFPRE], C.p16(WS_WGU), D, 64 * kb, n0, 256 * (n0 / 128) + 128 * which + (n0 % 128), which ? -0.6931471805599453f : -1.4426950408889634f}; return t; } r -= 2 * TI_GU;
    { const int nb = r % (D / 32), kb = r / (D / 32); t = TrItem{C.in[I_WFD], D, nullptr, C.p16(WS_WDN), FFH, 64 * kb, 32 * nb, 32 * nb, 1.0f}; return t; } }

typedef GAS unsigned gu32;
#define LDS_WAIT() asm volatile("s_waitcnt lgkmcnt(0)" ::: "memory")
#define VM_WAIT() asm volatile("s_waitcnt vmcnt(0)" ::: "memory")
#define XB_TMO      128
#define XB_XCNT(j)  (256  + 64 * (j))
#define XB_XSUB(j)  (1280 + 64 * (j))
#define XB_XGEN(j)  (2304 + 64 * (j))
#define XB_TOP      3328
#define XB_TOPGEN   3392
#define XCD_BAR_WORDS 3456
#define XB_SPIN_CAP (1u << 22)
__device__ __forceinline__ unsigned xb_ld(unsigned* p)              { return __hip_atomic_load(p, __ATOMIC_RELAXED, __HIP_MEMORY_SCOPE_AGENT); }
__device__ __forceinline__ unsigned xb_add(unsigned* p, unsigned v) { return __hip_atomic_fetch_add(p, v, __ATOMIC_RELAXED, __HIP_MEMORY_SCOPE_AGENT); }
__device__ __forceinline__ unsigned xb_xcc_id() { return (unsigned)__builtin_amdgcn_s_getreg((3 << 11) | 20) & 0xFu; }
#define XB_SPIN(cond, bar) do { unsigned _sp = 0; while (cond) { __builtin_amdgcn_s_sleep(1); \
    if ((++_sp & 255u) == 0u) { if (xb_ld(&(bar)[XB_TMO])) break; if (_sp > XB_SPIN_CAP) { atomicAdd(&(bar)[XB_TMO], 1u); break; } } } } while (0)
struct XcdBarrier { unsigned* bar; unsigned x; volatile LAS unsigned* st; };
__device__ __forceinline__ XcdBarrier xcd_barrier_post(unsigned* bar, volatile LAS unsigned* st) {
    XcdBarrier b; b.bar = bar; b.x = xb_xcc_id(); b.st = st;
    if (threadIdx.x == 0) (void)xb_add(&bar[XB_XCNT(b.x)], 1u);
    return b;
}
__device__ __forceinline__ void xcd_barrier_complete(unsigned* bar, unsigned x, unsigned& nloc, unsigned& nx) {
    const unsigned G = gridDim.x * gridDim.y * gridDim.z;
    unsigned sum, cnt, mine, sp = 0u;
    for (;;) {
        sum = 0u; cnt = 0u; mine = 0u;
#pragma unroll
        for (unsigned j = 0; j < 16; ++j) { const unsigned c = xb_ld(&bar[XB_XCNT(j)]); sum += c; cnt += (c > 0u) ? 1u : 0u; mine = (j == x) ? c : mine; }
        if (sum == G) break;
        __builtin_amdgcn_s_sleep(1);
        if ((++sp & 255u) == 0u) { if (xb_ld(&bar[XB_TMO])) break; if (sp > XB_SPIN_CAP) { atomicAdd(&bar[XB_TMO], 1u); break; } }
    }
    nloc = mine > 0u ? mine : 1u; nx = cnt > 0u ? cnt : 1u;
}
__device__ __forceinline__ void xcd_barrier(const XcdBarrier& b) {
    asm volatile("s_waitcnt vmcnt(0)" ::: "memory");
    __syncthreads();
    if (threadIdx.x == 0) {
        unsigned* bar = b.bar;
        __builtin_amdgcn_s_waitcnt(0);
        unsigned nloc = b.st[0], nx = b.st[1];
        if (nloc == 0u) { xcd_barrier_complete(bar, b.x, nloc, nx); b.st[0] = nloc; b.st[1] = nx; }
        const unsigned old = xb_add(&bar[XB_XSUB(b.x)], 1u);
        const unsigned gen = old / nloc;
        if (old + 1u == (gen + 1u) * nloc) {
            __builtin_amdgcn_fence(__ATOMIC_RELEASE, "agent");
            asm volatile("s_waitcnt vmcnt(0)" ::: "memory");
            const unsigned og = xb_add(&bar[XB_TOP], 1u);
            const unsigned tg = og / nx;
            if (og + 1u == (tg + 1u) * nx) xb_add(&bar[XB_TOPGEN], 1u);
            else XB_SPIN(xb_ld(&bar[XB_TOPGEN]) == tg, bar);
            __builtin_amdgcn_fence(__ATOMIC_ACQUIRE, "agent");
            xb_add(&bar[XB_XGEN(b.x)], 1u);
            asm volatile("s_waitcnt vmcnt(0)" ::: "memory");
        } else {
            XB_SPIN(xb_ld(&bar[XB_XGEN(b.x)]) == gen, bar);
            __builtin_amdgcn_fence(__ATOMIC_ACQUIRE, "agent");
            asm volatile("s_waitcnt vmcnt(0)" ::: "memory");
        }
    }
    __syncthreads();
}

__device__ __forceinline__ float wave_sum(float v) {
#pragma unroll
    for (int o = 1; o < 64; o <<= 1) v += __shfl_xor(v, o);
    return v;
}
__device__ __forceinline__ void transpose_item(const float* W, int ldw, const float* gain, float cs, bf16* WT, int ldk, int k0, int n0, int drow0, LAS float* scr, int lane) {
#pragma unroll 8
    for (int i = 0; i < 32; ++i) { const int kk = 2 * i + (lane >> 5); const float gsc = (gain ? gain[k0 + kk] : 1.0f) * cs; scr[kk * 33 + (lane & 31)] = W[(size_t)(k0 + kk) * ldw + n0 + (lane & 31)] * gsc; }
    LDS_WAIT(); asm volatile("" ::: "memory");
    const int c = lane & 7;
#pragma unroll
    for (int j = 0; j < 4; ++j) { const int n = (lane >> 3) + 8 * j; const LAS float* s = scr + (8 * c) * 33 + n;
        u32x4 o; o.x = pk2(s[0 * 33], s[1 * 33]); o.y = pk2(s[2 * 33], s[3 * 33]); o.z = pk2(s[4 * 33], s[5 * 33]); o.w = pk2(s[6 * 33], s[7 * 33]);
        *(u32x4*)(WT + (size_t)(drow0 + n) * ldk + k0 + 8 * c) = o; }
    LDS_WAIT(); asm volatile("" ::: "memory");
}
constexpr int NV = D / 256;
__device__ __forceinline__ void ld_row_f32(const float* r, int lane, f32x4 (&v)[NV]) {
#pragma unroll
    for (int j = 0; j < NV; ++j) v[j] = *((const f32x4*)r + 64 * j + lane); }
__device__ __forceinline__ void ld_row_f32_nt(const float* r, int lane, f32x4 (&v)[NV]) {
#pragma unroll
    for (int j = 0; j < NV; ++j) v[j] = __builtin_nontemporal_load((const f32x4*)r + 64 * j + lane); }
__device__ __forceinline__ void ld_row_bf(const bf16* r, int lane, f32x4 (&v)[NV]) {
#pragma unroll
    for (int j = 0; j < NV; ++j) { const u32x2 w = *((const u32x2*)r + 64 * j + lane); v[j] = (f32x4){bf2f(w.x), bf2f(w.x >> 16), bf2f(w.y), bf2f(w.y >> 16)}; } }
__device__ __forceinline__ void ld_row_bf_nt(const bf16* r, int lane, f32x4 (&v)[NV]) {
#pragma unroll
    for (int j = 0; j < NV; ++j) { const u32x2 w = __builtin_nontemporal_load((const u32x2*)r + 64 * j + lane); v[j] = (f32x4){bf2f(w.x), bf2f(w.x >> 16), bf2f(w.y), bf2f(w.y >> 16)}; } }
__device__ __forceinline__ float row_sumsq(const f32x4 (&v)[NV]) { float s = 0.f;
#pragma unroll
    for (int j = 0; j < NV; ++j) s += (v[j][0] * v[j][0] + v[j][1] * v[j][1]) + (v[j][2] * v[j][2] + v[j][3] * v[j][3]);
    return wave_sum(s); }
__device__ __forceinline__ void st_row_bf(bf16* r, int lane, const f32x4 (&v)[NV], float sc) {
#pragma unroll
    for (int j = 0; j < NV; ++j) { u32x2 w; w.x = pk2(v[j][0] * sc, v[j][1] * sc); w.y = pk2(v[j][2] * sc, v[j][3] * sc); *((u32x2*)r + 64 * j + lane) = w; } }

__device__ __forceinline__ void p0_prologue(const Ctx& C, LAS unsigned char* lds, int bx, int G, int lane, int wave) {
    LAS float* scr = (LAS float*)(lds + wave * 16384);
    const int NGW = G * 8, vw = wave * G + bx;
    const int gt = vw * 64 + lane, NGT = NGW * 64;
    for (int it = vw; it < N_TR_ITEMS; it += NGW) { const TrItem t = tr_decode(C, it); transpose_item(t.W, t.ldw, t.gain, t.cs, t.WT, t.ldk, t.k0, t.n0, t.drow0, scr, lane); }
    {
        LAS f32x2* tab = (LAS f32x2*)scr;
        for (int t = lane; t < 128; t += 64) { float sn, cs; sincospi_((float)t / 64.0f, &sn, &cs); tab[t] = (f32x2){cs, sn}; }
        LDS_WAIT(); asm volatile("" ::: "memory");
        constexpr int NIT = 4 * (D / 8) * 2;
        const float* wfo = C.in[I_WFO]; bf16* WFO = C.p16(WS_WFO);
        for (int it = vw; it < NIT; it += NGW) { const int jh = it & 1, dblk = (it >> 1) % (D / 8), g = it / (2 * (D / 8)); const int d = dblk * 8 + (lane >> 3), j0 = jh * 64 + (lane & 7) * 8;
            float ac[8], as[8];
#pragma unroll
            for (int q = 0; q < 8; ++q) { ac[q] = 0.f; as[q] = 0.f; }
            for (int m0 = 0; m0 < 128; m0 += 8) { float w8[8];
#pragma unroll
                for (int mm = 0; mm < 8; ++mm) w8[mm] = wfo[(size_t)(128 * g + m0 + mm) * D + d];
#pragma unroll
                for (int mm = 0; mm < 8; ++mm) {
#pragma unroll
                    for (int q = 0; q < 8; ++q) { const f32x2 cs = tab[((m0 + mm) * (j0 + q)) & 127]; ac[q] += cs[0] * w8[mm]; as[q] += cs[1] * w8[mm]; } } }
            const float sc = 0.08838834764831845f;
            u32x4 wc_, ws_; wc_.x = pk2(ac[0] * sc, ac[1] * sc); wc_.y = pk2(ac[2] * sc, ac[3] * sc); wc_.z = pk2(ac[4] * sc, ac[5] * sc); wc_.w = pk2(ac[6] * sc, ac[7] * sc);
            ws_.x = pk2(as[0] * sc, as[1] * sc); ws_.y = pk2(as[2] * sc, as[3] * sc); ws_.z = pk2(as[4] * sc, as[5] * sc); ws_.w = pk2(as[6] * sc, as[7] * sc);
            bf16* rp = WFO + (size_t)d * (2 * FW) + 128 * g + j0;
            *(u32x4*)rp = wc_; *(u32x4*)(rp + FW) = ws_; }
        LDS_WAIT(); asm volatile("" ::: "memory");
    }
    for (int e = gt; e < N_DFT_ITEMS; e += NGT) dft_item(C, e);
    for (int e = gt; e < N_TW_ITEMS; e += NGT) tw_item(C, e);
    for (int e = gt; e < N_LAML_ITEMS; e += NGT) laml_item(C, e);
    { LAS f32x2* tab = (LAS f32x2*)scr;
      for (int it = (vw + NGW - 4 * G) % NGW; it < N_KTW_ITEMS; it += NGW) { ktw_phase1(C, it, lane, tab); LDS_WAIT(); asm volatile("" ::: "memory"); ktw_phase2(C, it, lane, tab); LDS_WAIT(); asm volatile("" ::: "memory"); } }
    for (int e = gt; e < N_WINT_ITEMS; e += NGT) wint_item(C, e);
    for (int e = ((vw + NGW - 6 * G) % NGW) * 64 + lane; e < N_MFS2_ITEMS; e += NGT) mfs2_item(C, e);
    for (int tt = vw; tt < T; tt += NGW) { const int t = T - 1 - tt; f32x4 v[NV]; ld_row_f32_nt(C.xrow(t), lane, v); const float rs = 1.0f / sqrtf(row_sumsq(v) * (1.0f / D) + EPS); st_row_bf(C.XB() + (size_t)t * D, lane, v, rs); }
}
__device__ __forceinline__ void p1_toeplitz(const Ctx& C, int gt, int NGT) { for (int e = gt; e < N_TOEP_ITEMS; e += NGT) toep_item(C, e); }
template <int CS> __device__ __forceinline__ void scan_item(const Ctx& C, LAS unsigned char* lds, int it, int lane, int wave) {
    constexpr int CB = CS < 32 ? CS : 32, NB = CS / CB;
    const int dir = it & 1, g = (it >> 1) % NG, sq = it / (2 * NG);
    const int c0 = seq_start(sq) / LCH, nc = CS * 8;
    const f32x2 lam = ((const f32x2*)(C.ws + WS_LAML))[(g * 2 + dir) * NST + lane];
    const int k0 = wave * CS, chf = c0 + (dir == 0 ? k0 : nc - 1 - k0);
    const long xs = dir == 0 ? 256 : -256, us = dir == 0 ? KROW : -KROW;
    const bf16* xp0 = C.X() + (size_t)g * NCH * 256 + dir * 128 + lane * 2 + (size_t)chf * 256;
    bf16* up0 = C.US() + (size_t)g * NCH * KROW + KU + dir * 128 + lane * 2 + (size_t)chf * KROW;
    float sr = 0.f, si = 0.f;
    for (int b = 0; b < NB; ++b) { f32x2 xv[CB]; const bf16* xp = xp0 + (long)(b * CB) * xs;
#pragma unroll
        for (int q = 0; q < CB; ++q) { const unsigned w = *(const unsigned*)(xp + (long)q * xs); xv[q] = (f32x2){bf2f(w), bf2f(w >> 16)}; }
#pragma unroll
        for (int q = 0; q < CB; ++q) { const float nr = lam[0] * sr - lam[1] * si + xv[q][0], ni = lam[0] * si + lam[1] * sr + xv[q][1]; sr = nr; si = ni; } }
    LAS f32x2* ends = (LAS f32x2*)lds;
    ends[wave * 64 + lane] = (f32x2){sr, si};
    __syncthreads();
    float pr = lam[0], pi = lam[1];
#pragma unroll
    for (int t = 1; t < CS; t <<= 1) { const float nr = pr * pr - pi * pi, ni = 2.f * pr * pi; pr = nr; pi = ni; }
    float cr = 0.f, ci = 0.f;
    for (int w2 = 0; w2 < wave; ++w2) { const f32x2 e = ends[w2 * 64 + lane]; const float nr = pr * cr - pi * ci + e[0], ni = pr * ci + pi * cr + e[1]; cr = nr; ci = ni; }
    sr = cr; si = ci;
    for (int b = 0; b < NB; ++b) { f32x2 xv[CB]; const bf16* xp = xp0 + (long)(b * CB) * xs; bf16* up = up0 + (long)(b * CB) * us;
#pragma unroll
        for (int q = 0; q < CB; ++q) { const unsigned w = *(const unsigned*)(xp + (long)q * xs); xv[q] = (f32x2){bf2f(w), bf2f(w >> 16)}; }
#pragma unroll
        for (int q = 0; q < CB; ++q) { *(unsigned*)(up + (long)q * us) = pk2(sr, si);
            const float nr = lam[0] * sr - lam[1] * si + xv[q][0], ni = lam[0] * si + lam[1] * sr + xv[q][1]; sr = nr; si = ni; } }
    __syncthreads();
}
__device__ __forceinline__ void p3_scan(const Ctx& C, LAS unsigned char* lds, int bx, int G, int lane, int wave) {
    constexpr int CSP = SP / LCH / 8, CSS = SS / LCH / 8;
    static_assert((CSP & (CSP - 1)) == 0 && (CSS & (CSS - 1)) == 0 && CSP >= 1 && CSS >= 1, "scan segments");
    for (int it = bx; it < (NPB + 1) * NG * 2; it += G) { if (it / (2 * NG) < NPB) scan_item<CSP>(C, lds, it, lane, wave); else scan_item<CSS>(C, lds, it, lane, wave); }
}
__device__ __forceinline__ void p7_mid(const Ctx& C, int bx, int G, int lane, int wave) {
    f32x4 gp[NV]; ld_row_f32(C.in[I_NMPOST], lane, gp);
    for (int blk = bx; blk < T / 32; blk += G) {
#pragma unroll 1
        for (int r = 0; r < 4; ++r) { const int t = T - 1 - (blk * 32 + wave * 4 + r); f32x4 x[NV], mm[NV]; ld_row_f32_nt(C.xrow(t), lane, x); ld_row_bf_nt(C.MB() + (size_t)t * D, lane, mm);
            const float rm = 1.0f / sqrtf(row_sumsq(mm) * (1.0f / D) + EPS);
#pragma unroll
            for (int j = 0; j < NV; ++j) x[j] = x[j] + mm[j] * rm * gp[j];
            const float ms1 = row_sumsq(x) * (1.0f / D) + EPS, r1 = 1.0f / sqrtf(ms1);
            st_row_bf(C.X1B() + (size_t)t * D, lane, x, r1); if (lane == 0) C.p32(WS_IR1)[t] = sqrtf(ms1); } }
}
__device__ __forceinline__ void p10_final(const Ctx& C, int gw, int NGW, int lane) {
    f32x4 gf[NV]; ld_row_f32(C.in[I_NFPOST], lane, gf);
    for (int tt = gw; tt < T; tt += NGW) { const int t = T - 1 - tt; f32x4 x1[NV], ff[NV]; ld_row_bf_nt(C.X1B() + (size_t)t * D, lane, x1); ld_row_bf_nt(C.FB() + (size_t)t * D, lane, ff);
        const float ir1 = C.p32(WS_IR1)[t], rf = 1.0f / sqrtf(row_sumsq(ff) * (1.0f / D) + EPS);
        float* o = C.out + (size_t)t * D;
#pragma unroll
        for (int j = 0; j < NV; ++j) __builtin_nontemporal_store(x1[j] * ir1 + ff[j] * rf * gf[j], (f32x4*)o + 64 * j + lane); }
}
constexpr int NWAVES = 8, RING_BYTES = 131072, LDSCTL_OFF = RING_BYTES, MISC_OFF = LDSCTL_OFF + 320, LDS_BYTES = 147456;
constexpr int CW_BAR = 4096;
static_assert((CW_BAR + XCD_BAR_WORDS) * 4 <= (int)CTL_BYTES, "ctl");
struct Args { const float* in[22]; float* out; unsigned char* ws; };
#ifndef MK_SP2
#define MK_SP2 true
#endif
#ifndef MK_ALIGN
#define MK_ALIGN true
#endif
__global__ void __launch_bounds__(NWAVES * 64, 2) hyb_fwd(Args args) {
#if DEVCODE
    extern __shared__ __attribute__((aligned(16))) unsigned char lds_raw[];
    LAS unsigned char* lds = (LAS unsigned char*)lds_raw;
    volatile LAS unsigned* MISC = (volatile LAS unsigned*)(lds + MISC_OFF);
    const int tid = threadIdx.x, lane = tid & 63, wave = __builtin_amdgcn_readfirstlane(tid >> 6);
    const int G = gridDim.x, bx = blockIdx.x;
    Ctx C;
#pragma unroll
    for (int i = 0; i < 22; ++i) C.in[i] = args.in[i];
    C.out = args.out; C.ws = args.ws;
    for (int u = tid; u < (LDS_BYTES - LDSCTL_OFF) / 4; u += NWAVES * 64) ((LAS unsigned*)(lds + LDSCTL_OFF))[u] = 0u;
    __syncthreads();
    XcdBarrier bar = xcd_barrier_post((unsigned*)(C.ws + WS_CTL) + CW_BAR, MISC + 8);
    const int gw = bx * NWAVES + wave, NGW = G * NWAVES, gt = gw * 64 + lane, NGT = NGW * 64;
#define GRID_BAR() xcd_barrier(bar)
#define RUN(P) pg8::gemm_phase<decltype(P), MK_ALIGN, MK_SP2>(lds, P)
    p0_prologue(C, lds, bx, G, lane, wave);
    GRID_BAR();
    p1_toeplitz(C, gt, NGT);
    { ProbStd<EpiUs> P; P.init(C.XB(), D, C.p16(WS_WA), D, T, SW, D, G, bx); P.e = EpiUs{C.US()}; RUN(P); }
    { ProbUT P; P.init(C, 0, NPB, SP, G, bx); RUN(P); }
    { ProbUT P; P.init(C, TP, 1, SS, G, (bx + G / 2) % G); RUN(P); }
    GRID_BAR();
    if (G == 256 && P2_NXU % 256 != 0 && S1_NA > 0) { constexpr int rX = P2_NXU % 256, nl = 256 - rX; const int lc = bx - rX; const bool light = lc >= 0;
      { ProbS1 P; P.init(C, 0, S1_NA, SP, (const f32x2*)(C.ws + WS_TWP), 256, bx); RUN(P); }
      { ProbS1 P; P.init(C, S1_NA * SP, NPB - S1_NA, SP, (const f32x2*)(C.ws + WS_TWP), nl, light ? lc : (1 << 28)); RUN(P); }
      { ProbS1 P; P.init(C, TP, 1, SS, (const f32x2*)(C.ws + WS_TWS), nl, light ? (lc + nl - (S1_NB % nl)) % nl : (1 << 28)); RUN(P); }
    } else {
      { ProbS1 P; P.init(C, 0, NPB, SP, (const f32x2*)(C.ws + WS_TWP), G, bx); RUN(P); }
      { ProbS1 P; P.init(C, TP, 1, SS, (const f32x2*)(C.ws + WS_TWS), G, bx); RUN(P); } }
    { ProbX P; P.init(C, G, bx); RUN(P); }
    GRID_BAR();
    p3_scan(C, lds, bx, G, lane, wave);
    { ProbS2 P; P.init(C, 0, NPB, SP, C.p16(WS_A2P), G, bx); RUN(P); }
    { ProbS2 P; P.init(C, TP, 1, SS, C.p16(WS_A2S), G, (bx + G - (NPB * KAH * FW / 256) % G) % G); RUN(P); }
    GRID_BAR();
    { ProbY P; P.init(C, G, bx); RUN(P); }
    { ProbPQ P; P.init(C, G, (bx + G / 2) % G); RUN(P); }
    GRID_BAR();
    { ProbGlu P; P.init(C, G, bx); RUN(P); }
    GRID_BAR();
    { ProbStd<EpiGate> P; P.init(C.XB(), D, C.p16(WS_WA) + (size_t)SW * D, D, T, 2 * D, D, G, bx); P.e = EpiGate{C.PB(), C.QB(), C.BRB()}; RUN(P); }
    GRID_BAR();
    { ProbStd<EpiBf> P; P.init(C.BRB(), D, C.p16(WS_WO), D, T, D, D, G, bx); P.e = EpiBf{C.MB(), D}; RUN(P); }
    GRID_BAR();
    p7_mid(C, bx, G, lane, wave);
    GRID_BAR();
    { ProbStd<EpiFfn> P; P.init(C.X1B(), D, C.p16(WS_WGU), D, T, 2 * FFH, D, G, bx); P.e = EpiFfn{C.AB()}; RUN(P); }
    GRID_BAR();
    { ProbStd<EpiBf> P; P.init(C.AB(), FFH, C.p16(WS_WDN), FFH, T, D, FFH, G, bx); P.e = EpiBf{C.FB(), D}; RUN(P); }
    GRID_BAR();
    p10_final(C, gw, NGW, lane);
#endif
}

#ifndef HOST_EMU
extern "C" void kernel_launch(void* const* d_in, const int* in_sizes, int n_in, void* d_out, int out_size, void* d_ws, size_t ws_size, hipStream_t stream) {
    static int grid = 0;
    if (grid == 0) {
        if (n_in != 22 || out_size != T * D || ws_size < WS_END) { fprintf(stderr, "kernel_launch: unexpected shapes n_in %d out %d ws %zu (need %zu)\n", n_in, out_size, ws_size, (size_t)WS_END); grid = -1; return; }
        int dev = 0, cus = 0, per_cu = 0;
        if (hipGetDevice(&dev) != hipSuccess || hipDeviceGetAttribute(&cus, hipDeviceAttributeMultiprocessorCount, dev) != hipSuccess) { grid = -1; return; }
        if (hipFuncSetAttribute((const void*)hyb_fwd, hipFuncAttributeMaxDynamicSharedMemorySize, LDS_BYTES) != hipSuccess) { fprintf(stderr, "kernel_launch: hipFuncSetAttribute failed\n"); grid = -1; return; }
        if (hipOccupancyMaxActiveBlocksPerMultiprocessor(&per_cu, (const void*)hyb_fwd, 512, LDS_BYTES) != hipSuccess || per_cu < 1) fprintf(stderr, "kernel_launch: occupancy query says %d\n", per_cu);
        (void)hipGetLastError();
        grid = cus;
    }
    if (grid < 0) return;
    if (hipMemsetAsync((char*)d_ws + WS_CTL, 0, CTL_BYTES, stream) != hipSuccess) return;
    Args a{};
    for (int i = 0; i < 22; ++i) a.in[i] = (const float*)d_in[i];
    a.out = (float*)d_out; a.ws = (unsigned char*)d_ws;
    hipLaunchKernelGGL(hyb_fwd, dim3(grid), dim3(512), LDS_BYTES, stream, a);
}
#endif
```
